# Optimizing an MI355X kernel written in HIP

```python
import math
import jax, jax.numpy as jnp
from jax import lax
import numpy as np

D_MODEL = 1024
BATCH = 16
SEQ = 2048
DEPTH = 2

N_MIXERS = 2
N_NSA_LAYERS = (DEPTH + N_MIXERS - 1) // N_MIXERS
N_DIFF_LAYERS = DEPTH // N_MIXERS

REL_BUCKETS = 32
REL_MAX_DIST = 128
N_BIAS_MAPS = 16

NSA_HEADS = 16
NSA_GROUPS = 4
NSA_HPG = NSA_HEADS // NSA_GROUPS
NSA_HEAD_DIM = D_MODEL // NSA_HEADS
NSA_WIDTH = NSA_HEADS * NSA_HEAD_DIM
NSA_KV = NSA_GROUPS * NSA_HEAD_DIM
CMP_BLOCK = 32
CMP_STRIDE = 16
CMP_HIDDEN = 2 * NSA_HEAD_DIM
SEL_BLOCK = 64
SEL_TOPK = 8
WINDOW = 512
NSA_QBLOCK = 64
NSA_SPLIT_SIZES = [NSA_WIDTH] + [NSA_KV] * 6 + [3 * NSA_HEADS, NSA_WIDTH]
NSA_IN = sum(NSA_SPLIT_SIZES)

DIFF_HEADS = 8
DIFF_HALF = D_MODEL // (2 * DIFF_HEADS)
DIFF_VDIM = 2 * DIFF_HALF
DIFF_WIDTH = DIFF_HEADS * DIFF_VDIM
DIFF_IN = 4 * DIFF_WIDTH
DIFF_QBLOCK = 128

NEG = -1e30
BIG = 1e9
EPS = 1e-6

kernel_name = "hybrid_nsa_diffattn_sandwich"


def rmsnorm(x, g):
    xf = x.astype(jnp.float32)
    y = xf * lax.rsqrt(jnp.mean(xf * xf, axis=-1, keepdims=True) + EPS)
    return (y * g.astype(jnp.float32)).astype(x.dtype)


def rel_bucket(dist):
    n = jnp.maximum(dist, 0)
    max_exact = REL_BUCKETS // 2
    nf = jnp.maximum(n, 1).astype(jnp.float32)
    large = max_exact + (jnp.log(nf / max_exact) / math.log(REL_MAX_DIST / max_exact)
                         * (REL_BUCKETS - max_exact)).astype(jnp.int32)
    large = jnp.minimum(large, REL_BUCKETS - 1)
    return jnp.where(n < max_exact, n, large)


def compress(kv, pe, w1, w2):
    b, s, g, dh = kv.shape
    nc = (s - CMP_BLOCK) // CMP_STRIDE + 1
    idx = jnp.arange(nc)[:, None] * CMP_STRIDE + jnp.arange(CMP_BLOCK)[None, :]
    blocks = kv[:, idx] + pe[None, None, :, None, :]
    flat = jnp.moveaxis(blocks, 3, 2).reshape(b, nc, g, CMP_BLOCK * dh)
    return jax.nn.silu(flat @ w1) @ w2


def nsa_mixer(u, table, w_in, pe_k, w1_k, w2_k, pe_v, w1_v, w2_v, w_out):
    b, s, _ = u.shape
    G, J, dh = NSA_GROUPS, NSA_HPG, NSA_HEAD_DIM
    points = np.cumsum(NSA_SPLIT_SIZES)[:-1].tolist()
    q, kc, vc, ks, vs, kw, vw, gate, z = jnp.split(u @ w_in, points, axis=-1)
    q = q.reshape(b, s, G, J, dh) * (dh ** -0.5)
    kc, vc, ks, vs, kw, vw = [t.reshape(b, s, G, dh) for t in (kc, vc, ks, vs, kw, vw)]
    gate = jax.nn.sigmoid(gate.astype(jnp.float32)).reshape(b, s, G, J, 3)

    k_cmp = compress(kc, pe_k, w1_k, w2_k)
    v_cmp = compress(vc, pe_v, w1_v, w2_v)
    nc = k_cmp.shape[1]
    cmp_lo = jnp.arange(nc) * CMP_STRIDE
    cmp_end = cmp_lo + CMP_BLOCK - 1
    n_sel = s // SEL_BLOCK
    topk = min(SEL_TOPK, n_sel)
    sel_lo = jnp.arange(n_sel) * SEL_BLOCK
    overlap = jnp.clip(jnp.minimum(cmp_lo[:, None] + CMP_BLOCK, sel_lo[None, :] + SEL_BLOCK)
                       - jnp.maximum(cmp_lo[:, None], sel_lo[None, :]), 0).astype(jnp.float32) / CMP_BLOCK

    table_g = table.reshape(REL_BUCKETS, G, J)
    table_gt = jnp.transpose(table_g, (1, 0, 2))
    ks_t = jnp.transpose(ks, (0, 2, 1, 3))
    vs_t = jnp.transpose(vs, (0, 2, 1, 3))
    kw_pad = jnp.pad(kw, ((0, 0), (WINDOW, 0), (0, 0), (0, 0)))
    vw_pad = jnp.pad(vw, ((0, 0), (WINDOW, 0), (0, 0), (0, 0)))
    bi = jnp.arange(b)[:, None, None, None]
    gi = jnp.arange(G)[None, :, None, None]
    blk_n = jnp.arange(n_sel)

    def block(qb):
        start = qb * NSA_QBLOCK
        t = start + jnp.arange(NSA_QBLOCK)
        qblk = lax.dynamic_slice_in_dim(q, start, NSA_QBLOCK, axis=1)

        dist_c = t[:, None] - cmp_end[None, :]
        m_c = dist_c >= 0
        bias_c = jnp.transpose(table_g[rel_bucket(dist_c)], (2, 3, 0, 1))
        s_c = jnp.einsum('bqgjd,bcgd->bgjqc', qblk, k_cmp).astype(jnp.float32) + bias_c
        p_c = jax.nn.softmax(jnp.where(m_c, s_c, NEG), axis=-1) * jnp.any(m_c, axis=-1)[:, None]
        o_c = jnp.einsum('bgjqc,bcgd->bqgjd', p_c.astype(v_cmp.dtype), v_cmp)

        imp = jnp.einsum('bgjqc,cn->bgqn', p_c, overlap)
        cur = t // SEL_BLOCK
        forced = (blk_n[None, :] == 0) | (blk_n[None, :] == cur[:, None]) | (blk_n[None, :] == cur[:, None] - 1)
        future = blk_n[None, :] > cur[:, None]
        imp = jnp.where(forced, BIG, jnp.where(future, -BIG, imp))
        _, sel = lax.top_k(imp, topk)
        pos = (sel[..., None] * SEL_BLOCK + jnp.arange(SEL_BLOCK)).reshape(b, G, NSA_QBLOCK, topk * SEL_BLOCK)
        k_g = ks_t[bi, gi, pos]
        v_g = vs_t[bi, gi, pos]
        dist_s = t[None, None, :, None] - pos
        bias_s = jnp.moveaxis(table_gt[gi, rel_bucket(dist_s)], -1, 2)
        s_s = jnp.einsum('bqgjd,bgqkd->bgjqk', qblk, k_g).astype(jnp.float32) + bias_s
        p_s = jax.nn.softmax(jnp.where((dist_s >= 0)[:, :, None], s_s, NEG), axis=-1)
        o_s = jnp.einsum('bgjqk,bgqkd->bqgjd', p_s.astype(v_g.dtype), v_g)

        k_win = lax.dynamic_slice_in_dim(kw_pad, start, NSA_QBLOCK + WINDOW, axis=1)
        v_win = lax.dynamic_slice_in_dim(vw_pad, start, NSA_QBLOCK + WINDOW, axis=1)
        pos_w = start - WINDOW + jnp.arange(NSA_QBLOCK + WINDOW)
        dist_w = t[:, None] - pos_w[None, :]
        m_w = (dist_w >= 0) & (dist_w < WINDOW) & (pos_w[None, :] >= 0)
        bias_w = jnp.transpose(table_g[rel_bucket(dist_w)], (2, 3, 0, 1))
        s_w = jnp.einsum('bqgjd,bkgd->bgjqk', qblk, k_win).astype(jnp.float32) + bias_w
        p_w = jax.nn.softmax(jnp.where(m_w, s_w, NEG), axis=-1)
        o_w = jnp.einsum('bgjqk,bkgd->bqgjd', p_w.astype(v_win.dtype), v_win)
        return o_c, o_s, o_w

    o_c, o_s, o_w = lax.map(block, jnp.arange(s // NSA_QBLOCK))
    o_c, o_s, o_w = [jnp.moveaxis(o, 0, 1).reshape(b, s, G, J, dh) for o in (o_c, o_s, o_w)]
    o = gate[..., 0:1] * o_c + gate[..., 1:2] * o_s + gate[..., 2:3] * o_w
    o = o.astype(u.dtype).reshape(b, s, NSA_WIDTH) * jax.nn.silu(z)
    return o @ w_out


def diff_mixer(u, table, w_in, lq1, lk1, lq2, lk2, subln, w_out, lambda_init):
    b, s, _ = u.shape
    H, d, dv = DIFF_HEADS, DIFF_HALF, DIFF_VDIM
    q, k, v, z = jnp.split(u @ w_in, 4, axis=-1)
    q = q.reshape(b, s, H, 2, d) * (d ** -0.5)
    k = k.reshape(b, s, H, 2, d)
    v = v.reshape(b, s, H, dv)
    lam = (jnp.exp(jnp.sum(lq1.astype(jnp.float32) * lk1.astype(jnp.float32)))
           - jnp.exp(jnp.sum(lq2.astype(jnp.float32) * lk2.astype(jnp.float32))) + lambda_init)
    table_h = table.reshape(REL_BUCKETS, H, 2)
    kpos = jnp.arange(s)

    def block(qb):
        start = qb * DIFF_QBLOCK
        t = start + jnp.arange(DIFF_QBLOCK)
        qblk = lax.dynamic_slice_in_dim(q, start, DIFF_QBLOCK, axis=1)
        dist = t[:, None] - kpos[None, :]
        bias = jnp.transpose(table_h[rel_bucket(dist)], (2, 3, 0, 1))
        sc = jnp.einsum('bqhmd,bkhmd->bhmqk', qblk, k).astype(jnp.float32) + bias
        p = jax.nn.softmax(jnp.where(dist >= 0, sc, NEG), axis=-1)
        a = p[:, :, 0] - lam * p[:, :, 1]
        return jnp.einsum('bhqk,bkhe->bqhe', a.astype(v.dtype), v)

    o = lax.map(block, jnp.arange(s // DIFF_QBLOCK))
    o = jnp.moveaxis(o, 0, 1).reshape(b, s, H, dv)
    o = rmsnorm(o, subln.reshape(H, dv)) * (1.0 - lambda_init)
    o = o.reshape(b, s, DIFF_WIDTH) * jax.nn.silu(z)
    return o @ w_out


def setup_inputs(seed: int = 0) -> dict:
    key = jax.random.key(seed)
    ks = jax.random.split(key, 20)
    nrm = jax.random.normal
    f32 = jnp.float32
    A, Bn = N_NSA_LAYERS, N_DIFF_LAYERS
    ld = CMP_BLOCK * NSA_HEAD_DIM
    return {
        "x": nrm(ks[0], (BATCH, SEQ, D_MODEL), f32),
        "rel_bias_table": 0.3 * nrm(ks[1], (REL_BUCKETS, N_BIAS_MAPS), f32),
        "norm_pre": 1.0 + 0.05 * nrm(ks[2], (DEPTH, D_MODEL), f32),
        "norm_post": 1.0 + 0.05 * nrm(ks[3], (DEPTH, D_MODEL), f32),
        "nsa_w_in": nrm(ks[4], (A, D_MODEL, NSA_IN), f32) * D_MODEL ** -0.5,
        "nsa_cmp_pe_k": 0.5 * nrm(ks[5], (A, CMP_BLOCK, NSA_HEAD_DIM), f32),
        "nsa_cmp_w1_k": nrm(ks[6], (A, ld, CMP_HIDDEN), f32) * ld ** -0.5,
        "nsa_cmp_w2_k": nrm(ks[7], (A, CMP_HIDDEN, NSA_HEAD_DIM), f32) * CMP_HIDDEN ** -0.5,
        "nsa_cmp_pe_v": 0.5 * nrm(ks[8], (A, CMP_BLOCK, NSA_HEAD_DIM), f32),
        "nsa_cmp_w1_v": nrm(ks[9], (A, ld, CMP_HIDDEN), f32) * ld ** -0.5,
        "nsa_cmp_w2_v": nrm(ks[10], (A, CMP_HIDDEN, NSA_HEAD_DIM), f32) * CMP_HIDDEN ** -0.5,
        "nsa_w_out": nrm(ks[11], (A, NSA_WIDTH, D_MODEL), f32) * NSA_WIDTH ** -0.5,
        "diff_w_in": nrm(ks[12], (Bn, D_MODEL, DIFF_IN), f32) * D_MODEL ** -0.5,
        "diff_lambda_q1": 0.1 * nrm(ks[13], (Bn, DIFF_HALF), f32),
        "diff_lambda_k1": 0.1 * nrm(ks[14], (Bn, DIFF_HALF), f32),
        "diff_lambda_q2": 0.1 * nrm(ks[15], (Bn, DIFF_HALF), f32),
        "diff_lambda_k2": 0.1 * nrm(ks[16], (Bn, DIFF_HALF), f32),
        "diff_subln": 1.0 + 0.05 * nrm(ks[17], (Bn, DIFF_WIDTH), f32),
        "diff_w_out": nrm(ks[18], (Bn, DIFF_WIDTH, D_MODEL), f32) * DIFF_WIDTH ** -0.5,
    }


def reference(x, rel_bias_table, norm_pre, norm_post, nsa_w_in, nsa_cmp_pe_k, nsa_cmp_w1_k,
              nsa_cmp_w2_k, nsa_cmp_pe_v, nsa_cmp_w1_v, nsa_cmp_w2_v, nsa_w_out, diff_w_in,
              diff_lambda_q1, diff_lambda_k1, diff_lambda_q2, diff_lambda_k2, diff_subln, diff_w_out):
    for i in range(DEPTH):
        u = rmsnorm(x, norm_pre[i])
        j = i // N_MIXERS
        if i % N_MIXERS == 0:
            y = nsa_mixer(u, rel_bias_table, nsa_w_in[j], nsa_cmp_pe_k[j], nsa_cmp_w1_k[j],
                          nsa_cmp_w2_k[j], nsa_cmp_pe_v[j], nsa_cmp_w1_v[j], nsa_cmp_w2_v[j],
                          nsa_w_out[j])
        else:
            lambda_init = 0.8 - 0.6 * math.exp(-0.3 * i)
            y = diff_mixer(u, rel_bias_table, diff_w_in[j], diff_lambda_q1[j], diff_lambda_k1[j],
                           diff_lambda_q2[j], diff_lambda_k2[j], diff_subln[j], diff_w_out[j],
                           lambda_init)
        x = x + rmsnorm(y, norm_post[i])
    return x
```

```cpp
#include <hip/hip_runtime.h>
#include <hip/hip_cooperative_groups.h>
#include <cstdio>
#include <cstdint>
namespace cg = cooperative_groups;

#ifndef PROBE_DUP
#define PROBE_DUP -1
#endif
#ifndef MK_ONE_LAUNCH
#define MK_ONE_LAUNCH 1
#endif

namespace pg8 {
#define PG8_LAS __attribute__((address_space(3)))
typedef unsigned short bf16_t;
typedef short bf16x8 __attribute__((ext_vector_type(8)));
typedef float f32x4 __attribute__((ext_vector_type(4)));
typedef unsigned u32x4 __attribute__((ext_vector_type(4)));
constexpr int BM = 256, BK = 64, HALF = 128, HTB = HALF * BK * 2  , STAGE_BYTES = 8 * HTB, NXCD = 8, WGM = 8;

__host__ __device__ __forceinline__ int lds_byte(int r, int c) { const int st = (r >> 4) * 2 + (c >> 5), rr = r & 15, cc = c & 31, ob = rr * 64 + cc * 2; return st * 1024 + (ob ^ (((ob >> 9) & 1) << 5)); }
__host__ __device__ __forceinline__ void stage_rc(int b, int& R, int& C) { const int st = b / 1024, sb = b % 1024, swz = sb ^ (((sb >> 9) & 1) << 5); R = (st >> 1) * 16 + swz / 64; C = (st & 1) * 32 + (swz % 64) / 2; }
__host__ __device__ __forceinline__ int perm32(int rho) { const int n = rho >> 4, i = rho & 15; return 8 * (i >> 2) + 4 * n + (i & 3); }

struct Unit { int pm, pn; };
struct Gemm { const bf16_t* A; const bf16_t* Bt; int M, N, K; };

struct StaticOrder {
    int nM, nN, nwg, G, c;
    __host__ __device__ void init(int M, int N, int G_, int c_) { nM = M / BM; nN = N / BM; nwg = nM * nN; G = G_; c = c_; }
    __host__ __device__ bool next(int i, Unit& u) const {
        const long L = (long)i * G + c; if (L >= nwg) return false;
        int wgid = (int)L; { const int q = nwg / NXCD, r = nwg % NXCD, xcd = wgid % NXCD, off = wgid / NXCD; wgid = (xcd < r ? xcd * (q + 1) : r * (q + 1) + (xcd - r) * q) + off; }
        const int nig = WGM * nN, gid = wgid / nig, fm = gid * WGM, gsz = (nM - fm) < WGM ? (nM - fm) : WGM;
        u.pm = fm + ((wgid % nig) % gsz); u.pn = (wgid % nig) / gsz; return true;
    }
    __device__ __forceinline__ void a_ready(const Unit&) const {}
    __device__ __forceinline__ void done(const Unit&) const {}
};


typedef float f32x2_t __attribute__((ext_vector_type(2))); typedef __bf16 bf16x2_t __attribute__((ext_vector_type(2)));
__device__ __forceinline__ unsigned cvtpk(float lo, float hi) { f32x2_t v = {lo, hi}; bf16x2_t b = __builtin_convertvector(v, bf16x2_t); return __builtin_bit_cast(unsigned, b); }
typedef unsigned u32x2w __attribute__((ext_vector_type(2)));
__device__ __forceinline__ void st8_wt(void* p, u32x2w v) { asm volatile("global_store_dwordx2 %0, %1, off sc1\n\ts_nop 1" :: "v"(p), "v"(v) : "memory"); }
__device__ __forceinline__ void st16_wt(void* p, u32x4 v) { asm volatile("global_store_dwordx4 %0, %1, off sc1\n\ts_nop 1" :: "v"(p), "v"(v) : "memory"); }
__device__ __forceinline__ float silu_f(float v) { return v * __builtin_amdgcn_rcpf(1.0f + __builtin_amdgcn_exp2f(-1.4426950408889634f * v)); }
__device__ __forceinline__ float sigm_f(float v) { return __builtin_amdgcn_rcpf(1.0f + __builtin_amdgcn_exp2f(-1.4426950408889634f * v)); }

constexpr int SEQ_ = 2048;
constexpr int EPI_RS = 80, EPI_WS = 32 * EPI_RS;
template <int LAYER> struct EpiMix {
    static constexpr bool PERM = true, AFTER_DRAIN = false;
    bf16_t *Q, *KC, *VC, *KS, *VST, *KW, *VWT, *SZ; float* GATE; float qscale; PG8_LAS unsigned char* epl;
    __device__ __forceinline__ void operator()(const f32x4 (&acc)[2][2][4][2], const Unit& u, int wr, int wc, int fr, int fq) const {
        const int pn = u.pn;
        const int row0 = u.pm * BM + wr * 64 + fr, cin = wc * 32 + 8 * fq;
        int kind = 0, ld = 1024, coloff = 0, act = 0; float sc = 1.f; bf16_t* dst = Q; int nfeat = 256, featoff = 0;
        if (LAYER == 0) {
            if (pn < 4) { dst = Q; ld = 1024; coloff = pn * 256; sc = qscale; }
            else if (pn == 4) { dst = KC; ld = 256; }
            else if (pn == 5) { dst = VC; ld = 256; }
            else if (pn == 6) { dst = KS; ld = 256; }
            else if (pn == 7) { kind = 1; dst = VST; nfeat = 256; }
            else if (pn == 8) { dst = KW; ld = 256; }
            else if (pn == 9) { kind = 1; dst = VWT; nfeat = 256; }
            else if (pn < 14) { dst = SZ; ld = 1024; coloff = (pn - 10) * 256; act = 1; }
            else kind = 2;
        } else if (LAYER == 1) {
            if (pn < 4) { dst = Q; coloff = pn * 256; sc = qscale; }
            else if (pn < 8) { dst = KC; coloff = (pn - 4) * 256; }
            else if (pn < 12) { kind = 1; dst = VST; nfeat = 1024; featoff = (pn - 8) * 256; }
            else { dst = SZ; coloff = (pn - 12) * 256; act = 1; }
        } else { dst = Q; coloff = pn * 256; }
        if (kind == 1) {
            const int lane_ = (int)(threadIdx.x & 63);
            PG8_LAS unsigned char* stg = epl + (wr * 4 + wc) * EPI_WS;
            const int frp = (fr & 3) | ((fr & 4) << 1) | ((fr & 8) >> 1), par = fr & 1;
            const unsigned sel = par ? 0x03020706u : 0x05040100u;
            PG8_LAS unsigned* wp = (PG8_LAS unsigned*)(stg + (8 * fq + par) * EPI_RS) + (frp >> 1);
#pragma unroll
            for (int ai = 0; ai < 2; ++ai) {
                const int R = u.pm * BM + ai * HALF + wr * 64, b = R / SEQ_, tb = R % SEQ_;
#pragma unroll
                for (int bj = 0; bj < 2; ++bj) {
                    bf16_t* gbase = dst + ((size_t)b * nfeat + featoff + wc * 32 + bj * HALF) * SEQ_ + tb;
#pragma unroll
                    for (int mp = 0; mp < 2; ++mp) {
#pragma unroll
                        for (int mq = 0; mq < 2; ++mq) {
                            const f32x4 v0 = acc[ai][bj][2 * mp + mq][0], v1 = acc[ai][bj][2 * mp + mq][1];
                            unsigned w[4]; w[0] = cvtpk(v0[0], v0[1]); w[1] = cvtpk(v0[2], v0[3]); w[2] = cvtpk(v1[0], v1[1]); w[3] = cvtpk(v1[2], v1[3]);
#pragma unroll
                            for (int k = 0; k < 4; ++k) { const unsigned pw = (unsigned)__builtin_amdgcn_update_dpp(0, (int)w[k], 0xB1, 0xf, 0xf, true);
                                wp[(2 * k * EPI_RS) / 4 + mq * 8] = __builtin_amdgcn_perm(pw, w[k], sel); }
                        }
                        asm volatile("s_waitcnt lgkmcnt(0)" ::: "memory");
#pragma unroll
                        for (int i = 0; i < 2; ++i) { const int idx = lane_ + 64 * i, f = idx >> 2, q4 = idx & 3;
                            const u32x4 o = *(const PG8_LAS u32x4*)(stg + f * EPI_RS + q4 * 16);
                            st16_wt(gbase + (size_t)f * SEQ_ + 32 * mp + 8 * q4, o); }
                    }
                }
            }
            return;
        }
#pragma unroll
        for (int ai = 0; ai < 2; ++ai)
#pragma unroll
            for (int m = 0; m < 4; ++m) {
                const int row = row0 + ai * HALF + m * 16;
#pragma unroll
                for (int bj = 0; bj < 2; ++bj) {
                    f32x4 v0 = acc[ai][bj][m][0], v1 = acc[ai][bj][m][1];
                    const int c = cin + bj * HALF;
                    if (kind == 0) {
                        if (act == 1) {
#pragma unroll
                            for (int e = 0; e < 4; ++e) { v0[e] = silu_f(v0[e]); v1[e] = silu_f(v1[e]); }
                        }
                        v0 = v0 * sc; v1 = v1 * sc;
                        u32x4 w; w.x = cvtpk(v0[0], v0[1]); w.y = cvtpk(v0[2], v0[3]); w.z = cvtpk(v1[0], v1[1]); w.w = cvtpk(v1[2], v1[3]);
                        if (act == 1) __builtin_nontemporal_store(w, (u32x4*)(dst + (size_t)row * ld + coloff + c)); else st16_wt(dst + (size_t)row * ld + coloff + c, w);
                    } else {
                        if (c < 48) {
                            f32x4 g0, g1;
#pragma unroll
                            for (int e = 0; e < 4; ++e) { g0[e] = sigm_f(v0[e]); g1[e] = sigm_f(v1[e]); }
                            float* gp = GATE + (size_t)row * 48 + c;
                            *(f32x4*)gp = g0; *(f32x4*)(gp + 4) = g1;
                        }
                    }
                }
            }
    }
};

template <class Epi, class Sched, bool ALIGN_EPI = false, bool SP2 = false>
__device__ __forceinline__ void gemm_phase(PG8_LAS unsigned char* lds, const Gemm g, const Sched& S, const Epi& E) {
    const int tid = threadIdx.x, wid = __builtin_amdgcn_readfirstlane(tid >> 6), lane = tid & 63, wr = wid >> 2, wc = wid & 3, fr = lane & 15, fq = lane >> 4;
    const int K = g.K, nt = K / BK;
    unsigned voffA[2], voffB[2];
#pragma unroll
    for (int i = 0; i < 2; ++i) { int R, C; stage_rc(tid * 16 + i * 8192, R, C); const int Rb = Epi::PERM ? ((R & ~31) + perm32(R & 31)) : R;
        voffA[i] = (unsigned)(R * K + C) * 2u; voffB[i] = (unsigned)(Rb * K + C) * 2u; }
    const size_t kstep = (size_t)(BK * 2);
    const size_t hstep = (size_t)HALF * K * 2;
    const size_t tstep = 2 * hstep;
    const unsigned ldsw = (unsigned)wid * 1024u;
    const int aoff = lds_byte(wr * 64 + fr, fq * 8), boff = lds_byte(wc * 32 + fr, fq * 8);
#define PG8_SA(b, h) (((b) * 2 + (h)) * HTB)
#define PG8_SB(b, h) ((4 + (b) * 2 + (h)) * HTB)
#define PG8_STAGE(bufoff, gbase, voff) do { _Pragma("unroll") for (int _i = 0; _i < 2; ++_i) \
        __builtin_amdgcn_global_load_lds((const unsigned*)((const char*)(gbase) + (voff)[_i]), (PG8_LAS unsigned*)(lds + (bufoff) + ldsw + _i * 8192), 16, 0, 0); } while (0)
#define PG8_LDA(dst, b, h) do { _Pragma("unroll") for (int m = 0; m < 4; ++m) _Pragma("unroll") for (int k = 0; k < 2; ++k) dst[m][k] = *(const PG8_LAS bf16x8*)(lds + PG8_SA(b, h) + aoff + m * 2048 + k * 1024); } while (0)
#define PG8_LDB(dst, b, h) do { _Pragma("unroll") for (int n = 0; n < 2; ++n) _Pragma("unroll") for (int k = 0; k < 2; ++k) dst[n][k] = *(const PG8_LAS bf16x8*)(lds + PG8_SB(b, h) + boff + n * 2048 + k * 1024); } while (0)
#define PG8_MMA(ai, bj, At, Bt) do { __builtin_amdgcn_s_setprio(1); _Pragma("unroll") for (int m = 0; m < 4; ++m) _Pragma("unroll") for (int n = 0; n < 2; ++n) _Pragma("unroll") for (int k = 0; k < 2; ++k) \
        acc[ai][bj][m][n] = __builtin_amdgcn_mfma_f32_16x16x32_bf16(Bt[n][k], At[m][k], acc[ai][bj][m][n], 0, 0, 0); __builtin_amdgcn_s_setprio(0); } while (0)
#define PG8_WAIT_V(n) asm volatile("s_waitcnt vmcnt(" #n ")" ::: "memory")
#define PG8_WAIT_L(n) asm volatile("s_waitcnt lgkmcnt(" #n ")" ::: "memory")
#define PG8_BAR __builtin_amdgcn_s_barrier()
#define PG8_SCHED __builtin_amdgcn_sched_barrier(0)
    Unit cur, nxt; int ui = 0;
    if (!S.next(0, cur)) return;
    f32x4 acc[2][2][4][2];
#pragma unroll
    for (int a = 0; a < 2; ++a)
#pragma unroll
        for (int b = 0; b < 2; ++b)
#pragma unroll
            for (int m = 0; m < 4; ++m)
#pragma unroll
                for (int n = 0; n < 2; ++n) acc[a][b][m][n] = (f32x4){0.f, 0.f, 0.f, 0.f};
    bf16x8 At[4][2], B0[2][2], B1[2][2];
    const char* cA = (const char*)g.A + (size_t)cur.pm * tstep; const char* cB = (const char*)g.Bt + (size_t)cur.pn * tstep;
    S.a_ready(cur);
    if constexpr (SP2) {
        PG8_STAGE(PG8_SB(0, 0), cB, voffB); PG8_STAGE(PG8_SB(0, 1), cB + hstep, voffB); PG8_STAGE(PG8_SA(0, 0), cA, voffA); PG8_STAGE(PG8_SA(0, 1), cA + hstep, voffA);
        if (wr == 1) PG8_BAR;
        PG8_WAIT_V(2); PG8_BAR;
        PG8_STAGE(PG8_SB(1, 0), cB + kstep, voffB); PG8_STAGE(PG8_SA(1, 0), cA + kstep, voffA); PG8_STAGE(PG8_SB(1, 1), cB + hstep + kstep, voffB);
        PG8_WAIT_V(6); PG8_BAR;
    } else {
        PG8_STAGE(PG8_SB(0, 0), cB, voffB); PG8_STAGE(PG8_SA(0, 0), cA, voffA); PG8_STAGE(PG8_SB(0, 1), cB + hstep, voffB); PG8_STAGE(PG8_SA(0, 1), cA + hstep, voffA);
        if (wr == 1) PG8_BAR;
        PG8_WAIT_V(4); PG8_BAR;
        PG8_STAGE(PG8_SB(1, 0), cB + kstep, voffB); PG8_STAGE(PG8_SA(1, 0), cA + kstep, voffA); PG8_STAGE(PG8_SB(1, 1), cB + hstep + kstep, voffB);
        PG8_WAIT_V(6); PG8_BAR;
    }
    for (;;) {
        const bool has_next = S.next(ui + 1, nxt);
        const char* nA = has_next ? (const char*)g.A + (size_t)nxt.pm * tstep : cA; const char* nB = has_next ? (const char*)g.Bt + (size_t)nxt.pn * tstep : cB;
        for (int t = 0; t < nt; t += 2) {
            const bool last = (t == nt - 2);
            const char* a1 = cA + (size_t)(t + 1) * kstep;
            const char* a2 = last ? nA : cA + (size_t)(t + 2) * kstep; const char* b2 = last ? nB : cB + (size_t)(t + 2) * kstep;
            const char* a3 = a2 + kstep; const char* b3 = b2 + kstep;
            if (last && has_next) S.a_ready(nxt);
            if constexpr (SP2) {
            PG8_LDB(B0, 0, 0); PG8_LDB(B1, 0, 1); PG8_SCHED; PG8_LDA(At, 0, 0); PG8_STAGE(PG8_SA(1, 1), a1 + hstep, voffA);
            PG8_WAIT_V(8); PG8_WAIT_L(0); PG8_BAR; PG8_MMA(0, 0, At, B0); PG8_MMA(0, 1, At, B1); PG8_BAR; PG8_SCHED;
            PG8_LDA(At, 0, 1); PG8_STAGE(PG8_SB(0, 0), b2, voffB); PG8_STAGE(PG8_SB(0, 1), b2 + hstep, voffB); PG8_STAGE(PG8_SA(0, 0), a2, voffA);
            PG8_WAIT_V(8); PG8_WAIT_L(0); PG8_BAR; PG8_MMA(1, 0, At, B0); PG8_MMA(1, 1, At, B1); PG8_BAR; PG8_SCHED;
            PG8_LDB(B0, 1, 0); PG8_LDB(B1, 1, 1); PG8_SCHED; PG8_LDA(At, 1, 0); PG8_STAGE(PG8_SA(0, 1), a2 + hstep, voffA);
            PG8_WAIT_V(8); PG8_WAIT_L(0); PG8_BAR; PG8_MMA(0, 0, At, B0); PG8_MMA(0, 1, At, B1); PG8_BAR; PG8_SCHED;
            PG8_LDA(At, 1, 1); PG8_STAGE(PG8_SB(1, 0), b3, voffB); PG8_STAGE(PG8_SB(1, 1), b3 + hstep, voffB); PG8_STAGE(PG8_SA(1, 0), a3, voffA);
            PG8_WAIT_V(8); PG8_WAIT_L(0); PG8_BAR; PG8_MMA(1, 0, At, B0); PG8_MMA(1, 1, At, B1); PG8_BAR; PG8_SCHED;
            } else {
            PG8_LDB(B0, 0, 0); PG8_SCHED; PG8_LDA(At, 0, 0); PG8_STAGE(PG8_SA(1, 1), a1 + hstep, voffA);
            PG8_WAIT_L(8); PG8_BAR; PG8_WAIT_L(0); PG8_MMA(0, 0, At, B0); PG8_BAR; PG8_SCHED;
            PG8_LDB(B1, 0, 1); PG8_STAGE(PG8_SB(0, 0), b2, voffB);
            PG8_BAR; PG8_WAIT_L(0); PG8_MMA(0, 1, At, B1); PG8_BAR;
            PG8_LDA(At, 0, 1); PG8_STAGE(PG8_SA(0, 0), a2, voffA);
            PG8_BAR; PG8_WAIT_L(0); PG8_MMA(1, 0, At, B0); PG8_BAR; PG8_SCHED;
            PG8_STAGE(PG8_SB(0, 1), b2 + hstep, voffB);
            PG8_WAIT_V(6); PG8_BAR; PG8_MMA(1, 1, At, B1); PG8_BAR;
            PG8_LDB(B0, 1, 0); PG8_SCHED; PG8_LDA(At, 1, 0); PG8_STAGE(PG8_SA(0, 1), a2 + hstep, voffA);
            PG8_WAIT_L(8); PG8_BAR; PG8_WAIT_L(0); PG8_MMA(0, 0, At, B0); PG8_BAR; PG8_SCHED;
            PG8_LDB(B1, 1, 1); PG8_STAGE(PG8_SB(1, 0), b3, voffB);
            PG8_BAR; PG8_WAIT_L(0); PG8_MMA(0, 1, At, B1); PG8_BAR;
            PG8_LDA(At, 1, 1); PG8_STAGE(PG8_SA(1, 0), a3, voffA);
            PG8_BAR; PG8_WAIT_L(0); PG8_MMA(1, 0, At, B0); PG8_BAR; PG8_SCHED;
            PG8_STAGE(PG8_SB(1, 1), b3 + hstep, voffB);
            PG8_WAIT_V(6); PG8_BAR; PG8_MMA(1, 1, At, B1); PG8_BAR;
            }
        }
        if constexpr (ALIGN_EPI) { if (wr == 0) PG8_BAR; }
        if constexpr (!Epi::AFTER_DRAIN) { E(acc, cur, wr, wc, fr, fq); S.done(cur); }
        if (!has_next) break;
#pragma unroll
        for (int a = 0; a < 2; ++a)
#pragma unroll
            for (int b = 0; b < 2; ++b)
#pragma unroll
                for (int m = 0; m < 4; ++m)
#pragma unroll
                    for (int n = 0; n < 2; ++n) acc[a][b][m][n] = (f32x4){0.f, 0.f, 0.f, 0.f};
        cur = nxt; cA = nA; cB = nB; ++ui;
        if constexpr (ALIGN_EPI) { if (wr == 1) PG8_BAR; }
    }
    PG8_WAIT_V(0);
    if constexpr (!ALIGN_EPI) { if (wr == 0) PG8_BAR; }
    PG8_BAR;
    if constexpr (Epi::AFTER_DRAIN) { E.fused(acc, cur, wr, wc, fr, fq, lds, wid, lane); S.done(cur); }
#undef PG8_SA
#undef PG8_SB
#undef PG8_STAGE
#undef PG8_LDA
#undef PG8_LDB
#undef PG8_MMA
#undef PG8_WAIT_V
#undef PG8_WAIT_L
#undef PG8_BAR
#undef PG8_SCHED
}
}

#define LAS __attribute__((address_space(3)))
typedef unsigned short bf16_t;
typedef short bf16x8 __attribute__((ext_vector_type(8)));
typedef float f32x4 __attribute__((ext_vector_type(4)));
typedef float f32x16 __attribute__((ext_vector_type(16)));
typedef unsigned u32x4 __attribute__((ext_vector_type(4)));
typedef unsigned u32x2 __attribute__((ext_vector_type(2)));
using pg8::cvtpk;

constexpr int NB = 16, SEQ = 2048, DM = 1024, MTOK = NB * SEQ;
constexpr int N0PAD = 3840, N1 = 4096;
constexpr float EPS = 1e-6f;
constexpr float LOG2E = 1.4426950408889634f;
constexpr float QSCALE = 0.125f * LOG2E;
constexpr float LAMBDA_INIT = 0.35550906759f;
constexpr int NWAVES = 8, NTHREADS = 512;
constexpr int LDS_BYTES = 155648;
constexpr int LDS_MISC = 131072 + 1024;
constexpr int LDS_EPI = LDS_MISC + 1024;
static_assert(LDS_EPI + 8 * pg8::EPI_WS <= LDS_BYTES, "lds");

constexpr size_t MiB = 1u << 20;
constexpr size_t WS_BAR = 65536, WS_BAR_BYTES = 16384;
constexpr int LPAD = 96, LUTN = 320;
constexpr size_t WS_LUT = 16384, WS_B1K = 12288, WS_B1V = 12800, WS_LAM = 13312;
constexpr size_t WS_W0T = 2 * MiB, WS_WO0T = 10 * MiB, WS_WDT = 12 * MiB, WS_WO1T = 20 * MiB;
constexpr size_t WS_W1KT = 22 * MiB, WS_W1VT = 22 * MiB + 512 * 1024, WS_W2KT = 23 * MiB, WS_W2VT = 23 * MiB + 65536;
constexpr size_t WS_KCMP = 24 * MiB, WS_VCMPT = 25 * MiB, WS_GATE = 26 * MiB;
constexpr size_t WS_R0 = 32 * MiB, WS_R1 = 96 * MiB, WS_R2 = 160 * MiB, WS_R3 = 224 * MiB, WS_R4 = 288 * MiB, WS_X1B = 352 * MiB, WS_END = 416 * MiB;

struct Args { const float* in[19]; float* out; unsigned char* ws; int ph_lo, ph_hi; };

struct Ctx {
    LAS unsigned char* lds;
    int tid, lane, wave, vcu, G;
};

template <int CTRL> __device__ __forceinline__ float dpp_f(float v) { return __int_as_float(__builtin_amdgcn_update_dpp(0, __float_as_int(v), CTRL, 0xf, 0xf, true)); }
template <int CTRL> __device__ __forceinline__ int dpp_i(int v) { return __builtin_amdgcn_update_dpp(0, v, CTRL, 0xf, 0xf, true); }
constexpr int DPP_XOR1 = 0xB1, DPP_XOR2 = 0x4E, DPP_HALF_MIRROR = 0x141, DPP_ROW_MIRROR = 0x140;
__device__ __forceinline__ float wave_sum(float v) {
    v += dpp_f<DPP_XOR1>(v); v += dpp_f<DPP_XOR2>(v); v += dpp_f<DPP_HALF_MIRROR>(v); v += dpp_f<DPP_ROW_MIRROR>(v);
    { auto rr = __builtin_amdgcn_permlane16_swap(__float_as_uint(v), __float_as_uint(v), false, false); v = __uint_as_float(rr[0]) + __uint_as_float(rr[1]); }
    { auto rr = __builtin_amdgcn_permlane32_swap(__float_as_uint(v), __float_as_uint(v), false, false); v = __uint_as_float(rr[0]) + __uint_as_float(rr[1]); }
    return v;
}
__device__ __forceinline__ float bf2f(unsigned h) { return __uint_as_float(h << 16); }
__device__ __forceinline__ int crow(int r, int hi) { return (r & 3) + 8 * (r >> 2) + 4 * hi; }
#define LDS_WAIT() asm volatile("s_waitcnt lgkmcnt(0)" ::: "memory")

__device__ __forceinline__ void transpose_item(const float* W, int K, int Nsrc, bf16_t* WT, int nblk, int item, bool remap, LAS float* scr, int lane) {
    const int kb = item / nblk, nb = item % nblk, k0 = 64 * kb, n0 = 32 * nb;
    const int n = n0 + (lane & 31);
    int src = n; bool valid = true;
    if (remap) { if (n >= 3632) valid = false; else if (n >= 3584) src = n - 1024; else if (n >= 2560) src = n + 48; }
    float tv[32];
#pragma unroll
    for (int i = 0; i < 32; ++i) { const int kk = 2 * i + (lane >> 5); tv[i] = valid ? W[(size_t)(k0 + kk) * Nsrc + src] : 0.f; }
#pragma unroll
    for (int i = 0; i < 32; ++i) { const int kk = 2 * i + (lane >> 5); scr[kk * 33 + (lane & 31)] = tv[i]; }
    LDS_WAIT(); asm volatile("" ::: "memory");
    const int c = lane & 7;
#pragma unroll
    for (int j = 0; j < 4; ++j) { const int nn = (lane >> 3) + 8 * j; const LAS float* s = scr + (8 * c) * 33 + nn;
        u32x4 o; o.x = cvtpk(s[0 * 33], s[1 * 33]); o.y = cvtpk(s[2 * 33], s[3 * 33]); o.z = cvtpk(s[4 * 33], s[5 * 33]); o.w = cvtpk(s[6 * 33], s[7 * 33]);
        *(u32x4*)(WT + (size_t)(n0 + nn) * K + k0 + 8 * c) = o; }
    LDS_WAIT(); asm volatile("" ::: "memory");
}
__device__ __forceinline__ void rms_row_to_bf16(const float* xrow, const float* g, bf16_t* orow, int lane) {
    const f32x4* xr = (const f32x4*)xrow + lane; const f32x4* gr = (const f32x4*)g + lane;
    f32x4 v[4]; float s = 0.f;
#pragma unroll
    for (int j = 0; j < 4; ++j) { v[j] = xr[64 * j]; s += (v[j].x * v[j].x + v[j].y * v[j].y) + (v[j].z * v[j].z + v[j].w * v[j].w); }
    const float r = rsqrtf(wave_sum(s) * (1.f / DM) + EPS);
    u32x2* o8 = (u32x2*)orow + lane;
#pragma unroll
    for (int j = 0; j < 4; ++j) { const f32x4 gv = gr[64 * j]; u32x2 w; w.x = cvtpk(v[j].x * r * gv.x, v[j].y * r * gv.y); w.y = cvtpk(v[j].z * r * gv.z, v[j].w * r * gv.w); o8[64 * j] = w; }
}
__device__ __forceinline__ int rel_bucket(int n) {
    if (n < 16) return n;
    int lg = 16 + (int)(logf((float)n / 16.0f) / 2.0794415416798357f * 16.0f);
    return lg < 31 ? lg : 31;
}
__device__ __forceinline__ void p0_prologue(const Ctx& C, const Args& a) {
    unsigned char* ws = a.ws;
    LAS float* scr = (LAS float*)(C.lds + C.wave * 16384);
    const int gw = C.vcu * NWAVES + C.wave, NGW = C.G * NWAVES;
    constexpr int I_W0 = 16 * (N0PAD / 32), I_W1 = 32 * 4, I_W2 = 2 * 2;
    constexpr int NITEMS = I_W0 + 2 * I_W1 + 2 * I_W2;
    const int gwm = C.wave * C.G + C.vcu;
    for (int it = gwm; it < NITEMS; it += NGW) {
        int r = it;
        if (r < I_W0) { transpose_item(a.in[4], 1024, 3632, (bf16_t*)(ws + WS_W0T), N0PAD / 32, r, true, scr, C.lane); continue; } r -= I_W0;
        if (r < I_W1) { transpose_item(a.in[6], 2048, 128, (bf16_t*)(ws + WS_W1KT), 4, r, false, scr, C.lane); continue; } r -= I_W1;
        if (r < I_W1) { transpose_item(a.in[9], 2048, 128, (bf16_t*)(ws + WS_W1VT), 4, r, false, scr, C.lane); continue; } r -= I_W1;
        if (r < I_W2) { transpose_item(a.in[7], 128, 64, (bf16_t*)(ws + WS_W2KT), 2, r, false, scr, C.lane); continue; } r -= I_W2;
        transpose_item(a.in[10], 128, 64, (bf16_t*)(ws + WS_W2VT), 2, r, false, scr, C.lane);
    }
    for (int it = gwm - C.G; it < 256; it += NGW) {
        if (it < 0) continue;
        const int kv = it >> 7, n = it & 127;
        const float* pe = kv ? a.in[8] : a.in[5]; const float* w1 = kv ? a.in[9] : a.in[6];
        float s = 0.f, pv[32], wv[32];
#pragma unroll
        for (int i = 0; i < 32; ++i) { const int k = C.lane + 64 * i; pv[i] = pe[k]; wv[i] = w1[(size_t)k * 128 + n]; }
#pragma unroll
        for (int i = 0; i < 32; ++i) s += pv[i] * wv[i];
        s = wave_sum(s);
        if (C.lane == 0) ((float*)(ws + (kv ? WS_B1V : WS_B1K)))[n] = s;
    }
    for (int it = gwm - 2 * C.G; it < 16 * LUTN / 64; it += NGW) {
        if (it < 0) continue;
        const int idx = it * 64 + C.lane, map = idx / LUTN, dist = idx % LUTN - LPAD;
        ((float*)(ws + WS_LUT))[idx] = dist < 0 ? -INFINITY : a.in[1][rel_bucket(dist > 127 ? 127 : dist) * 16 + map] * LOG2E;
    }
    if (gwm == 3 * C.G) {
        const float p1 = wave_sum(a.in[13][C.lane] * a.in[14][C.lane]), p2 = wave_sum(a.in[15][C.lane] * a.in[16][C.lane]);
        if (C.lane == 0) *(float*)(ws + WS_LAM) = expf(p1) - expf(p2) + LAMBDA_INIT;
    }
    bf16_t* U0 = (bf16_t*)(ws + WS_R0);
    if (gw < MTOK) {
        f32x4 va[2][4], vb[2][4], g0v[4];
        _Pragma("unroll") for (int j = 0; j < 4; ++j) g0v[j] = ((const f32x4*)a.in[2] + C.lane)[64 * j];
#define P0_LOAD(v, m) do { const int m2_ = (m) + NGW; \
        const f32x4* x0_ = (const f32x4*)(a.in[0] + (size_t)(m) * DM) + C.lane; const f32x4* x1_ = (const f32x4*)(a.in[0] + (size_t)(m2_ < MTOK ? m2_ : (m)) * DM) + C.lane; \
        _Pragma("unroll") for (int j = 0; j < 4; ++j) { v[0][j] = __builtin_nontemporal_load(x0_ + 64 * j); v[1][j] = __builtin_nontemporal_load(x1_ + 64 * j); } } while (0)
#define P0_PROC(v, m) do { const int m2_ = (m) + NGW; float s0 = 0.f, s1 = 0.f; \
        _Pragma("unroll") for (int j = 0; j < 4; ++j) { s0 += (v[0][j].x * v[0][j].x + v[0][j].y * v[0][j].y) + (v[0][j].z * v[0][j].z + v[0][j].w * v[0][j].w); s1 += (v[1][j].x * v[1][j].x + v[1][j].y * v[1][j].y) + (v[1][j].z * v[1][j].z + v[1][j].w * v[1][j].w); } \
        const float r0 = rsqrtf(wave_sum(s0) * (1.f / DM) + EPS), r1 = rsqrtf(wave_sum(s1) * (1.f / DM) + EPS); \
        u32x2* o0 = (u32x2*)(U0 + (size_t)(m) * DM) + C.lane; u32x2* o1 = (u32x2*)(U0 + (size_t)m2_ * DM) + C.lane; \
        _Pragma("unroll") for (int j = 0; j < 4; ++j) { const f32x4 gv = g0v[j]; \
            u32x2 w; w.x = cvtpk(v[0][j].x * r0 * gv.x, v[0][j].y * r0 * gv.y); w.y = cvtpk(v[0][j].z * r0 * gv.z, v[0][j].w * r0 * gv.w); pg8::st8_wt(o0 + 64 * j, w); \
            if (m2_ < MTOK) { u32x2 w1; w1.x = cvtpk(v[1][j].x * r1 * gv.x, v[1][j].y * r1 * gv.y); w1.y = cvtpk(v[1][j].z * r1 * gv.z, v[1][j].w * r1 * gv.w); pg8::st8_wt(o1 + 64 * j, w1); } } } while (0)
        P0_LOAD(va, gw);
#pragma unroll 1
        for (int m = gw; m < MTOK; m += 4 * NGW) {
            const int m1 = m + 2 * NGW, m2 = m + 4 * NGW;
            if (m1 < MTOK) P0_LOAD(vb, m1);
            P0_PROC(va, m);
            if (m1 >= MTOK) break;
            if (m2 < MTOK) P0_LOAD(va, m2);
            P0_PROC(vb, m1);
        }
#undef P0_LOAD
#undef P0_PROC
    }
}

__device__ __forceinline__ void late_transposes(const Ctx& C, const Args& a, int first) {
    unsigned char* ws = a.ws;
    LAS float* scr = (LAS float*)(C.lds + C.wave * 16384);
    const int gw = ((int)blockIdx.x - first) * NWAVES + C.wave, NGW = (C.G - first) * NWAVES;
    constexpr int I_WO = 16 * 32, I_WD = 16 * (N1 / 32);
    for (int it = gw; it < 2 * I_WO + I_WD; it += NGW) {
        int r = it;
        if (r < I_WO) { transpose_item(a.in[11], 1024, 1024, (bf16_t*)(ws + WS_WO0T), 32, r, false, scr, C.lane); continue; } r -= I_WO;
        if (r < I_WD) { transpose_item(a.in[12], 1024, 4096, (bf16_t*)(ws + WS_WDT), 128, r, false, scr, C.lane); continue; } r -= I_WD;
        transpose_item(a.in[18], 1024, 1024, (bf16_t*)(ws + WS_WO1T), 32, r, false, scr, C.lane);
    }
}

__device__ __forceinline__ void compress_phase(const Ctx& C, const Args& a) {
    unsigned char* ws = a.ws;
    const int lane = C.lane, wid = C.wave, rg = wid & 3, ch = wid >> 2, fr = lane & 15, fq = lane >> 4;
    constexpr int CST = 544;
    LAS unsigned char* AT = C.lds;
    LAS unsigned char* BT = C.lds + 64 * CST;
    LAS bf16_t* H = (LAS bf16_t*)(C.lds + 64 * CST + 128 * CST);
    const int tid = C.tid;
    for (int u = C.vcu; u < 256; u += C.G) {
        const int kv = u & 1, half = (u >> 1) & 1, bg = u >> 2, b = bg >> 2, g = bg & 3;
        const bf16_t* src = (const bf16_t*)(ws + WS_R2 + (kv ? 16 * MiB : 0)) + (size_t)b * SEQ * 256 + g * 64;
        const bf16_t* w1t = (const bf16_t*)(ws + (kv ? WS_W1VT : WS_W1KT));
        const bf16_t* w2t = (const bf16_t*)(ws + (kv ? WS_W2VT : WS_W2KT));
        const float* b1 = (const float*)(ws + (kv ? WS_B1V : WS_B1K));
        f32x4 acc[4];
#pragma unroll
        for (int nt = 0; nt < 4; ++nt) acc[nt] = (f32x4){0.f, 0.f, 0.f, 0.f};
        u32x4 ar[4], br[8];
#define CMP_LOAD(pp) do { \
        _Pragma("unroll") for (int i = 0; i < 4; ++i) { const int idx = tid + NTHREADS * i, cc = idx >> 5, l = (idx >> 3) & 3, c16 = idx & 7; int tok = 16 * (half * 64 + cc) + 4 * (pp) + l; tok = tok > SEQ - 1 ? SEQ - 1 : tok; \
            ar[i] = *(const u32x4*)(src + (size_t)tok * 256 + c16 * 8); } \
        _Pragma("unroll") for (int i = 0; i < 8; ++i) { const int idx = tid + NTHREADS * i, n = idx >> 5, ck = idx & 31; br[i] = *(const u32x4*)(w1t + (size_t)n * 2048 + 256 * (pp) + ck * 8); } } while (0)
        CMP_LOAD(0);
#pragma unroll 1
        for (int pp = 0; pp < 8; ++pp) {
            __syncthreads();
#pragma unroll
            for (int i = 0; i < 4; ++i) { const int idx = tid + NTHREADS * i, cc = idx >> 5, l = (idx >> 3) & 3, c16 = idx & 7; *(LAS u32x4*)(AT + cc * CST + l * 128 + c16 * 16) = ar[i]; }
#pragma unroll
            for (int i = 0; i < 8; ++i) { const int idx = tid + NTHREADS * i, n = idx >> 5, ck = idx & 31; *(LAS u32x4*)(BT + n * CST + ck * 16) = br[i]; }
            __syncthreads();
            if (pp + 1 < 8) CMP_LOAD(pp + 1);
#pragma unroll
            for (int ks = 0; ks < 8; ++ks) {
                const bf16x8 af = *(const LAS bf16x8*)(AT + (rg * 16 + fr) * CST + ks * 64 + fq * 16);
#pragma unroll
                for (int nt = 0; nt < 4; ++nt) { const bf16x8 bfr = *(const LAS bf16x8*)(BT + (ch * 64 + nt * 16 + fr) * CST + ks * 64 + fq * 16);
                    acc[nt] = __builtin_amdgcn_mfma_f32_16x16x32_bf16(af, bfr, acc[nt], 0, 0, 0); }
            }
        }
#undef CMP_LOAD
#pragma unroll
        for (int nt = 0; nt < 4; ++nt) { const int col = ch * 64 + nt * 16 + fr; const float bb = b1[col];
#pragma unroll
            for (int r = 0; r < 4; ++r) { const float hv = pg8::silu_f(acc[nt][r] + bb); H[(rg * 16 + 4 * fq + r) * 136 + col] = (bf16_t)(cvtpk(hv, 0.f) & 0xffffu); } }
        __syncthreads();
        f32x4 o2[2]; o2[0] = (f32x4){0.f, 0.f, 0.f, 0.f}; o2[1] = (f32x4){0.f, 0.f, 0.f, 0.f};
#pragma unroll
        for (int ks = 0; ks < 4; ++ks) {
            const bf16x8 af = *(const LAS bf16x8*)(H + (rg * 16 + fr) * 136 + ks * 32 + 8 * fq);
#pragma unroll
            for (int nt = 0; nt < 2; ++nt) { const bf16x8 bfr = *(const bf16x8*)(w2t + (size_t)(ch * 32 + nt * 16 + fr) * 128 + ks * 32 + 8 * fq);
                o2[nt] = __builtin_amdgcn_mfma_f32_16x16x32_bf16(af, bfr, o2[nt], 0, 0, 0); }
        }
        const int c0 = half * 64 + rg * 16 + 4 * fq;
#pragma unroll
        for (int nt = 0; nt < 2; ++nt) { const int d = ch * 32 + nt * 16 + fr;
            if (kv == 0) { bf16_t* kc = (bf16_t*)(ws + WS_KCMP) + (size_t)bg * 128 * 64;
#pragma unroll
                for (int r = 0; r < 4; ++r) { const int cc = c0 + r; kc[cc * 64 + d] = (cc == 127) ? (bf16_t)0 : (bf16_t)(cvtpk(o2[nt][r], 0.f) & 0xffffu); }
            } else { bf16_t* vc = (bf16_t*)(ws + WS_VCMPT) + (size_t)bg * 64 * 128;
                u32x2 w; w.x = cvtpk(o2[nt][0], o2[nt][1]); w.y = cvtpk(o2[nt][2], (c0 + 3 == 127) ? 0.f : o2[nt][3]);
                *(u32x2*)(vc + d * 128 + ((c0 & ~15) | ((c0 & 4) << 1) | ((c0 & 8) >> 1))) = w; }
        }
        __syncthreads();
    }
}

#define MFMA32(a, b, c) __builtin_amdgcn_mfma_f32_32x32x16_bf16((a), (b), (c), 0, 0, 0)
constexpr float NEG_INF = -INFINITY;
constexpr float RESCALE_THR = 6.0f;

__device__ __forceinline__ float xhalf_max(float v) { auto rr = __builtin_amdgcn_permlane32_swap(__float_as_uint(v), __float_as_uint(v), false, false); return fmaxf(__uint_as_float(rr[0]), __uint_as_float(rr[1])); }
__device__ __forceinline__ float xhalf_sum(float v) { auto rr = __builtin_amdgcn_permlane32_swap(__float_as_uint(v), __float_as_uint(v), false, false); return __uint_as_float(rr[0]) + __uint_as_float(rr[1]); }

template <int RS>
__device__ __forceinline__ void lds_frag8(bf16x8 (&f)[8], unsigned addr) {
    asm volatile("ds_read_b128 %0, %8\n\tds_read_b128 %1, %8 offset:%c9\n\tds_read_b128 %2, %8 offset:32\n\tds_read_b128 %3, %8 offset:%c10\n\t"
                 "ds_read_b128 %4, %8 offset:64\n\tds_read_b128 %5, %8 offset:%c11\n\tds_read_b128 %6, %8 offset:96\n\tds_read_b128 %7, %8 offset:%c12"
                 : "=&v"(f[0]), "=&v"(f[1]), "=&v"(f[2]), "=&v"(f[3]), "=&v"(f[4]), "=&v"(f[5]), "=&v"(f[6]), "=&v"(f[7])
                 : "v"(addr), "i"(RS), "i"(RS + 32), "i"(RS + 64), "i"(RS + 96));
}
template <int RS>
__device__ __forceinline__ void lds_frag8v(bf16x8 (&f)[8], unsigned addr) {
    asm volatile("ds_read_b128 %0, %8\n\tds_read_b128 %1, %8 offset:%c9\n\tds_read_b128 %2, %8 offset:%c10\n\tds_read_b128 %3, %8 offset:%c11\n\t"
                 "ds_read_b128 %4, %8 offset:32\n\tds_read_b128 %5, %8 offset:%c12\n\tds_read_b128 %6, %8 offset:%c13\n\tds_read_b128 %7, %8 offset:%c14"
                 : "=&v"(f[0]), "=&v"(f[1]), "=&v"(f[2]), "=&v"(f[3]), "=&v"(f[4]), "=&v"(f[5]), "=&v"(f[6]), "=&v"(f[7])
                 : "v"(addr), "i"(RS), "i"(2 * RS), "i"(3 * RS), "i"(RS + 32), "i"(2 * RS + 32), "i"(3 * RS + 32));
}
__device__ __forceinline__ void lds_wait8(bf16x8 (&f)[8]) {
    asm volatile("s_waitcnt lgkmcnt(0)" : "+v"(f[0]), "+v"(f[1]), "+v"(f[2]), "+v"(f[3]), "+v"(f[4]), "+v"(f[5]), "+v"(f[6]), "+v"(f[7]));
}
__device__ __forceinline__ void lds_wait16(bf16x8 (&f)[8], bf16x8 (&g)[8]) {
    asm volatile("s_waitcnt lgkmcnt(0)" : "+v"(f[0]), "+v"(f[1]), "+v"(f[2]), "+v"(f[3]), "+v"(f[4]), "+v"(f[5]), "+v"(f[6]), "+v"(f[7]),
                 "+v"(g[0]), "+v"(g[1]), "+v"(g[2]), "+v"(g[3]), "+v"(g[4]), "+v"(g[5]), "+v"(g[6]), "+v"(g[7]));
}
__device__ __forceinline__ void qk_frags(f32x16& p0, f32x16& p1, const bf16x8 (&kf)[8], const bf16x8 (&qf)[4], float init) {
#pragma unroll
    for (int r = 0; r < 16; ++r) { p0[r] = init; p1[r] = init; }
#pragma unroll
    for (int ds = 0; ds < 4; ++ds) { p0 = MFMA32(kf[2 * ds], qf[ds], p0); p1 = MFMA32(kf[2 * ds + 1], qf[ds], p1); }
}
__device__ __forceinline__ bf16x8 pack8(const f32x16& P, int base) {
    u32x4 pw; pw.x = cvtpk(P[base], P[base + 1]); pw.y = cvtpk(P[base + 2], P[base + 3]); pw.z = cvtpk(P[base + 4], P[base + 5]); pw.w = cvtpk(P[base + 6], P[base + 7]);
    return __builtin_bit_cast(bf16x8, pw);
}
__device__ __forceinline__ void near_bias(f32x16& p0, f32x16& p1, int D0, const LAS float* luth) {
    const LAS float* b = luth + (D0 - 59);
#pragma unroll
    for (int sub = 0; sub < 2; ++sub) {
        float bv[16];
#pragma unroll
        for (int r = 0; r < 16; ++r) bv[r] = b[59 - 32 * sub - (r & 3) - 8 * (r >> 2)];
#pragma unroll
        for (int r = 0; r < 16; ++r) asm volatile("" : "+v"(bv[r]));
#pragma unroll
        for (int r = 0; r < 16; ++r) { if (sub) p1[r] += bv[r]; else p0[r] += bv[r]; }
    }
}
__device__ __forceinline__ void far_mask(f32x16& p0, f32x16& p1, int D0, int dlim) {
#pragma unroll
    for (int e = 0; e < 32; ++e) { const int r = e & 15, sub = e >> 4; const int dist = D0 - 32 * sub - (r & 3) - 8 * (r >> 2);
        if (sub) p1[r] = (dist >= 0 && dist < dlim) ? p1[r] : NEG_INF; else p0[r] = (dist >= 0 && dist < dlim) ? p0[r] : NEG_INF; }
}
template <int ND>
__device__ __forceinline__ void softmax_decide(f32x16& p0, f32x16& p1, float& mref, float& l, bool& seen, f32x16 (&o)[ND]) {
    float a = fmaxf(fmaxf(p0[0], p0[1]), p1[0]), b = fmaxf(fmaxf(p0[2], p0[3]), p1[1]); a = fmaxf(fmaxf(a, p1[2]), p1[3]);
#pragma unroll
    for (int r = 4; r < 16; r += 4) { a = fmaxf(fmaxf(a, p0[r]), p0[r + 1]); b = fmaxf(fmaxf(b, p0[r + 2]), p0[r + 3]); a = fmaxf(fmaxf(a, p1[r]), p1[r + 1]); b = fmaxf(fmaxf(b, p1[r + 2]), p1[r + 3]); }
    const float rm = xhalf_max(fmaxf(a, b));
    const bool fin = rm > NEG_INF;
    const bool cond = fin && (!seen || rm > RESCALE_THR);
    if (__any(cond)) {
        const float dl = cond ? rm : 0.f;
        mref += dl;
#pragma unroll
        for (int r = 0; r < 16; ++r) { p0[r] -= dl; p1[r] -= dl; }
        const float alpha = seen ? __builtin_amdgcn_exp2f(-dl) : 1.f;
        l *= alpha;
#pragma unroll
        for (int dt = 0; dt < ND; ++dt) o[dt] = o[dt] * alpha;
    }
    seen = seen || fin;
}
template <int ND>
__device__ __forceinline__ void softmax_decide2(f32x16& a0, f32x16& a1, f32x16& b0, f32x16& b1, bool two, float& mref, float& l, bool& seen, f32x16 (&o)[ND]) {
    float x = fmaxf(fmaxf(a0[0], a0[1]), a1[0]), y = fmaxf(fmaxf(a0[2], a0[3]), a1[1]); x = fmaxf(fmaxf(x, a1[2]), a1[3]);
#pragma unroll
    for (int r = 4; r < 16; r += 4) { x = fmaxf(fmaxf(x, a0[r]), a0[r + 1]); y = fmaxf(fmaxf(y, a0[r + 2]), a0[r + 3]); x = fmaxf(fmaxf(x, a1[r]), a1[r + 1]); y = fmaxf(fmaxf(y, a1[r + 2]), a1[r + 3]); }
    if (two) {
#pragma unroll
        for (int r = 0; r < 16; r += 4) { x = fmaxf(fmaxf(x, b0[r]), b0[r + 1]); y = fmaxf(fmaxf(y, b0[r + 2]), b0[r + 3]); x = fmaxf(fmaxf(x, b1[r]), b1[r + 1]); y = fmaxf(fmaxf(y, b1[r + 2]), b1[r + 3]); }
    }
    const float rm = xhalf_max(fmaxf(x, y));
    const bool fin = rm > NEG_INF;
    const bool cond = fin && (!seen || rm > RESCALE_THR);
    if (__any(cond)) {
        const float dl = cond ? rm : 0.f;
        mref += dl;
#pragma unroll
        for (int r = 0; r < 16; ++r) { a0[r] -= dl; a1[r] -= dl; }
        if (two) {
#pragma unroll
            for (int r = 0; r < 16; ++r) { b0[r] -= dl; b1[r] -= dl; }
        }
        const float alpha = seen ? __builtin_amdgcn_exp2f(-dl) : 1.f;
        l *= alpha;
#pragma unroll
        for (int dt = 0; dt < ND; ++dt) o[dt] = o[dt] * alpha;
    }
    seen = seen || fin;
}
__device__ __forceinline__ float tile_max(const f32x16& p0, const f32x16& p1) {
    float a = fmaxf(fmaxf(p0[0], p0[1]), p1[0]), b = fmaxf(fmaxf(p0[2], p0[3]), p1[1]); a = fmaxf(fmaxf(a, p1[2]), p1[3]);
#pragma unroll
    for (int r = 4; r < 16; r += 4) { a = fmaxf(fmaxf(a, p0[r]), p0[r + 1]); b = fmaxf(fmaxf(b, p0[r + 2]), p0[r + 3]); a = fmaxf(fmaxf(a, p1[r]), p1[r + 1]); b = fmaxf(fmaxf(b, p1[r + 2]), p1[r + 3]); }
    return xhalf_max(fmaxf(a, b));
}
__device__ __forceinline__ float tile_max2(const f32x16& a0, const f32x16& a1, const f32x16& b0, const f32x16& b1, bool two) {
    float x = fmaxf(fmaxf(a0[0], a0[1]), a1[0]), y = fmaxf(fmaxf(a0[2], a0[3]), a1[1]); x = fmaxf(fmaxf(x, a1[2]), a1[3]);
#pragma unroll
    for (int r = 4; r < 16; r += 4) { x = fmaxf(fmaxf(x, a0[r]), a0[r + 1]); y = fmaxf(fmaxf(y, a0[r + 2]), a0[r + 3]); x = fmaxf(fmaxf(x, a1[r]), a1[r + 1]); y = fmaxf(fmaxf(y, a1[r + 2]), a1[r + 3]); }
    if (two) {
#pragma unroll
        for (int r = 0; r < 16; r += 4) { x = fmaxf(fmaxf(x, b0[r]), b0[r + 1]); y = fmaxf(fmaxf(y, b0[r + 2]), b0[r + 3]); x = fmaxf(fmaxf(x, b1[r]), b1[r + 1]); y = fmaxf(fmaxf(y, b1[r + 2]), b1[r + 3]); }
    }
    return xhalf_max(fmaxf(x, y));
}
template <int ND>
__device__ __forceinline__ float ref_move(float lpart, float& mref, float& l, f32x16 (&o)[ND]) {
    float dl = 0.f;
    if (__any(lpart > 512.0f)) {
        const float ssum = xhalf_sum(lpart);
        const bool cond = ssum > 1024.0f;
        dl = cond ? __builtin_amdgcn_logf(ssum) : 0.f;
        mref += dl;
        const float alpha = __builtin_amdgcn_exp2f(-dl);
        l *= alpha;
#pragma unroll
        for (int dt = 0; dt < ND; ++dt) o[dt] = o[dt] * alpha;
    }
    return dl;
}
__device__ __forceinline__ void softmax_exp1(f32x16& p, float& l) {
    float s0 = 0.f;
#pragma unroll
    for (int r = 0; r < 16; ++r) { p[r] = __builtin_amdgcn_exp2f(p[r]); s0 += p[r]; }
    l += s0;
}
__device__ __forceinline__ void softmax_exp(f32x16& p0, f32x16& p1, float& l) {
    float s0 = 0.f, s1 = 0.f;
#pragma unroll
    for (int r = 0; r < 16; ++r) { p0[r] = __builtin_amdgcn_exp2f(p0[r]); s0 += p0[r]; }
#pragma unroll
    for (int r = 0; r < 16; ++r) { p1[r] = __builtin_amdgcn_exp2f(p1[r]); s1 += p1[r]; }
    l += s0 + s1;
}

constexpr int NL_LUT = 0, NL_KCT = 16 * LUTN * 4, NL_VCT = NL_KCT + 128 * 144, NL_KT = NL_KCT, NL_VT = NL_KT + 4 * 9216,
              NL_IMP = NL_VT + 4 * 9216, NL_MASK = NL_IMP + 4 * 64 * 33 * 4, NL_UNI = NL_MASK + 256, NL_END = NL_MASK + 512;
static_assert(NL_VCT + 64 * 272 <= NL_IMP, "nsa lds overlay");
static_assert(NL_END <= 131072, "nsa lds");
__device__ __forceinline__ void nsa_phase(const Ctx& C, const Args& a) {
    unsigned char* ws = a.ws;
    LAS unsigned char* lds = C.lds;
    LAS float* LUT = (LAS float*)(lds + NL_LUT);
    LAS float* IMP = (LAS float*)(lds + NL_IMP);
    LAS unsigned* MASK = (LAS unsigned*)(lds + NL_MASK);
    LAS unsigned* UNI = (LAS unsigned*)(lds + NL_UNI);
    { u32x4 lv[3];
#pragma unroll
      for (int i = 0; i < 3; ++i) { const int idx = C.tid + NTHREADS * i; lv[i] = (idx < 16 * LUTN / 4) ? ((const u32x4*)(ws + WS_LUT))[idx] : (u32x4){}; }
#pragma unroll
      for (int i = 0; i < 3; ++i) { const int idx = C.tid + NTHREADS * i; if (idx < 16 * LUTN / 4) ((LAS u32x4*)LUT)[idx] = lv[i]; } }
    const bf16_t* Q0 = (const bf16_t*)(ws + WS_R1);
    const bf16_t* SZ = (const bf16_t*)(ws + WS_R4);
    bf16_t* O0 = (bf16_t*)(ws + WS_R0);
    const float* GATE = (const float*)(ws + WS_GATE);
    for (int it = 0;; ++it) {
        int bg, qb;
        if (C.G == 256) { if (it >= 8) break; const int x = C.vcu >> 5, c = C.vcu & 31, rr = it >> 1, p = ((c & 15) + 4 * rr) & 15, q = (c >> 4) ? 31 - p : p;
            bg = x * 8 + rr * 2 + (it & 1); qb = (it & 1) ? 31 - q : q; }
        else { const int u = C.vcu + it * C.G; if (u >= 2048) break; bg = u >> 5; qb = u & 31; }
        int tid = C.tid; asm volatile("" : "+v"(tid));
        const int lane = tid & 63, wid = __builtin_amdgcn_readfirstlane(tid >> 6), r32 = lane & 31, hi = lane >> 5, j = wid >> 1, th = wid & 1;
        const int b = bg >> 2, g = bg & 3, head = g * 4 + j, start = qb * 64, cur = qb;
        const size_t rowb = (size_t)b * SEQ;
        const int t = start + 32 * th + r32;
        {
            const bf16_t* kc = (const bf16_t*)(ws + WS_KCMP) + (size_t)bg * 128 * 64;
            const bf16_t* vc = (const bf16_t*)(ws + WS_VCMPT) + (size_t)bg * 64 * 128;
#pragma unroll
            for (int i = 0; i < 2; ++i) { const int idx = tid + NTHREADS * i;
                { const int row = idx >> 3, chn = idx & 7; const u32x4 v = *(const u32x4*)(kc + row * 64 + chn * 8); *(LAS u32x4*)(lds + NL_KCT + row * 144 + chn * 16) = v; }
                { const int row = idx >> 4, chn = idx & 15; const u32x4 v = *(const u32x4*)(vc + row * 128 + chn * 8); *(LAS u32x4*)(lds + NL_VCT + row * 272 + chn * 16) = v; } }
            if (tid < 64) MASK[tid] = 0u;
            if (tid == 64) UNI[0] = 0u;
        }
        bf16x8 qf[4];
        { const bf16_t* qp = Q0 + (rowb + t) * DM + head * 64 + 8 * hi;
#pragma unroll
          for (int ds = 0; ds < 4; ++ds) qf[ds] = *(const bf16x8*)(qp + 16 * ds); }
        const float* gp = GATE + (rowb + t) * 48 + head * 3; const float g0 = gp[0], g1 = gp[1], g2 = gp[2];
        const LAS float* luth = LUT + head * LUTN + LPAD;
        __syncthreads();
        unsigned accp[16];
        {
            f32x16 s[4];
            {
                const unsigned ka = (unsigned)(uintptr_t)(lds + NL_KCT + r32 * 144 + 16 * hi);
                bf16x8 kfa[8], kfb[8];
                lds_frag8<32 * 144>(kfa, ka); lds_wait8(kfa);
                qk_frags(s[0], s[1], kfa, qf, 0.f);
                if (cur >= 16) { lds_frag8<32 * 144>(kfb, ka + 64 * 144); lds_wait8(kfb); qk_frags(s[2], s[3], kfb, qf, 0.f); }
                else {
#pragma unroll
                    for (int r = 0; r < 16; ++r) { s[2][r] = NEG_INF; s[3][r] = NEG_INF; } }
            }
            float mx = NEG_INF; const int Dc = t - 31 - 64 * hi;
#pragma unroll
            for (int sub = 0; sub < 4; ++sub) {
                if (cur < 8 * sub) {
#pragma unroll
                    for (int r = 0; r < 16; ++r) s[sub][r] = NEG_INF;
                    continue; }
                if (cur >= 8 * sub + 10) {
                    const float cbc = luth[127];
#pragma unroll
                    for (int r = 0; r < 16; ++r) { const float v = s[sub][r] + cbc; s[sub][r] = v; mx = fmaxf(mx, v); }
                    continue; }
                float bv[16];
#pragma unroll
                for (int r = 0; r < 16; ++r) { const int dist = Dc - 512 * sub - 16 * (r & 3) - 128 * (r >> 2); int di = dist < 0 ? 0 : dist; di = di > 127 ? 127 : di; bv[r] = luth[di]; }
#pragma unroll
                for (int r = 0; r < 16; ++r) asm volatile("" : "+v"(bv[r]));
#pragma unroll
                for (int r = 0; r < 16; ++r) { const int dist = Dc - 512 * sub - 16 * (r & 3) - 128 * (r >> 2);
                    const float v = (dist >= 0) ? s[sub][r] + bv[r] : NEG_INF; s[sub][r] = v; mx = fmaxf(mx, v); }
            }
            mx = xhalf_max(mx);
            const float mu = (mx == NEG_INF) ? 0.f : mx; float sum = 0.f;
#pragma unroll
            for (int sub = 0; sub < 4; ++sub) {
                if (cur < 8 * sub) {
#pragma unroll
                    for (int r = 0; r < 16; ++r) s[sub][r] = 0.f;
                    continue; }
#pragma unroll
                for (int r = 0; r < 16; ++r) { s[sub][r] = __builtin_amdgcn_exp2f(s[sub][r] - mu); sum += s[sub][r]; }
            }
            sum = xhalf_sum(sum);
            const float inv = sum > 0.f ? 1.0f / sum : 0.f;
            if (cur >= 8) {
            float recv[4][4];
#pragma unroll
            for (int sub = 0; sub < 4; ++sub)
#pragma unroll
                for (int aa = 0; aa < 4; ++aa) { const float tv = 0.5f * inv * s[sub][4 * aa + 3]; auto rr = __builtin_amdgcn_permlane32_swap(__float_as_uint(tv), __float_as_uint(tv), false, false); recv[sub][aa] = __uint_as_float(hi ? rr[0] : rr[1]); }
            LAS float* imp = IMP + (j * 64 + 32 * th + r32) * 33;
#pragma unroll
            for (int sub = 0; sub < 4; ++sub)
#pragma unroll
                for (int aa = 0; aa < 4; ++aa) {
                    const float mainv = s[sub][4 * aa] + s[sub][4 * aa + 1] + s[sub][4 * aa + 2] + 0.5f * s[sub][4 * aa + 3];
                    const float prev = (aa > 0) ? recv[sub][aa > 0 ? aa - 1 : 0] : ((sub > 0) ? recv[sub > 0 ? sub - 1 : 0][3] : 0.f);
                    imp[8 * sub + 2 * aa + hi] = mainv * inv + (hi ? recv[sub][aa] : prev);
                }
            }
            f32x16 o[2]; o[0] = (f32x16){}; o[1] = (f32x16){};
            const unsigned va = (unsigned)(uintptr_t)(lds + NL_VCT + r32 * 272 + 16 * hi);
#pragma unroll
            for (int hb = 0; hb < 2; ++hb) {
                if (hb == 1 && cur < 16) continue;
                bf16x8 vf[8];
                lds_frag8<32 * 272>(vf, va + 128 * hb); lds_wait8(vf);
#pragma unroll
                for (int ks = 0; ks < 4; ++ks) { const bf16x8 pb = pack8(s[2 * hb + (ks >> 1)], 8 * (ks & 1)); o[0] = MFMA32(vf[2 * ks], pb, o[0]); o[1] = MFMA32(vf[2 * ks + 1], pb, o[1]); }
            }
#pragma unroll
            for (int dt = 0; dt < 2; ++dt)
#pragma unroll
                for (int r = 0; r < 16; r += 2) accp[dt * 8 + (r >> 1)] = cvtpk(o[dt][r] * (g0 * inv), o[dt][r + 1] * (g0 * inv));
        }
        __syncthreads();
        if (cur < 8) {
            if (tid < 64) MASK[tid] = 0xffffffffu >> (31 - cur);
            if (tid == 64) UNI[0] = 0xffffffffu >> (31 - cur);
            __syncthreads();
        } else {
            const int tok = tid >> 3, part = tid & 7;
            const LAS float* v0 = IMP + tok * 33;
            float v[4]; unsigned bits = 0u;
#pragma unroll
            for (int i = 0; i < 4; ++i) { const int n = part * 4 + i;
                const float val = ((v0[n] + v0[64 * 33 + n]) + v0[2 * 64 * 33 + n]) + v0[3 * 64 * 33 + n];
                const bool forced = (n == 0) || (n == cur) || (n == cur - 1), future = n > cur;
                if (forced) bits |= 1u << n;
                v[i] = (forced || future) ? -1.0f : val; }
#pragma unroll 1
            for (int round = 0; round < 5; ++round) {
                float bv = v[0]; int bi = part * 4;
#pragma unroll
                for (int i = 1; i < 4; ++i) { if (v[i] > bv) { bv = v[i]; bi = part * 4 + i; } }
#pragma unroll
                for (int st = 0; st < 3; ++st) { const float ov = st == 0 ? dpp_f<DPP_XOR1>(bv) : st == 1 ? dpp_f<DPP_XOR2>(bv) : dpp_f<DPP_HALF_MIRROR>(bv);
                    const int oi = st == 0 ? dpp_i<DPP_XOR1>(bi) : st == 1 ? dpp_i<DPP_XOR2>(bi) : dpp_i<DPP_HALF_MIRROR>(bi);
                    const bool take = (ov > bv) || (ov == bv && oi < bi); bv = take ? ov : bv; bi = take ? oi : bi; }
                if (bv >= 0.f && (bi >> 2) == part) { bits |= 1u << bi;
#pragma unroll
                    for (int i = 0; i < 4; ++i) if (part * 4 + i == bi) v[i] = -1.0f; }
            }
            if (bits) { __hip_atomic_fetch_or(MASK + tok, bits, __ATOMIC_RELAXED, __HIP_MEMORY_SCOPE_WORKGROUP); __hip_atomic_fetch_or(UNI, bits, __ATOMIC_RELAXED, __HIP_MEMORY_SCOPE_WORKGROUP); }
            __syncthreads();
        }
        LAS unsigned* ACCL = (LAS unsigned*)(lds + NL_IMP) + wid * 1024 + lane;
#pragma unroll
        for (int q = 0; q < 16; ++q) ACCL[q * 64] = accp[q];
        const unsigned mymask = MASK[32 * th + r32];
        const unsigned le_cur = 0xffffffffu >> (31 - cur);
        const unsigned selt = UNI[0] & le_cur;
        const int wlo = cur > 8 ? cur - 8 : 0;
        const unsigned wint = le_cur & ~((1u << wlo) - 1u);
        const float cb = luth[127];
#pragma unroll 1
        for (int br = 0; br < 2; ++br) {
            const bf16_t* Kg = (const bf16_t*)(ws + (br ? WS_R3 : WS_R2 + 32 * MiB)) + rowb * 256 + g * 64;
            const bf16_t* Vg = (const bf16_t*)(ws + (br ? WS_R3 + 16 * MiB : WS_R2 + 48 * MiB)) + ((size_t)b * 256 + g * 64) * SEQ;
            float mref = 0.f, l = 0.f; bool seen = false; f32x16 o[2]; o[0] = (f32x16){}; o[1] = (f32x16){};
            const int srow = tid >> 3, sch = tid & 7;
            const unsigned kra = (unsigned)(uintptr_t)(lds + NL_KT + r32 * 144 + 16 * hi);
            const unsigned vra = (unsigned)(uintptr_t)(lds + NL_VT + r32 * 144 + 16 * hi);
            LAS unsigned char* kst = lds + NL_KT + srow * 144 + sch * 16;
            LAS unsigned char* vst = lds + NL_VT + srow * 144 + sch * 16;
            const bf16_t* kgp = Kg + (size_t)srow * 256 + sch * 8;
            const bf16_t* vgp = Vg + (size_t)srow * SEQ + sch * 8;
            unsigned rem = br ? wint : selt;
            int ta = __builtin_ctz(rem); rem &= rem - 1u;
            int tb = rem ? __builtin_ctz(rem) : -1; if (tb >= 0) rem &= rem - 1u;
            u32x4 kA, vA, kB, vB;
            {
                const int tbb = tb >= 0 ? tb : ta;
                kA = *(const u32x4*)(kgp + (size_t)ta * (64 * 256)); vA = *(const u32x4*)(vgp + ta * 64);
                kB = *(const u32x4*)(kgp + (size_t)tbb * (64 * 256)); vB = *(const u32x4*)(vgp + tbb * 64);
                *(LAS u32x4*)kst = kA; *(LAS u32x4*)(kst + 9216) = kB; *(LAS u32x4*)vst = vA; *(LAS u32x4*)(vst + 9216) = vB;
            }
            __syncthreads();
#define NSA_LANEOK(tt) (br ? true : (((mymask >> (tt)) & 1u) != 0u))
#define NSA_INIT(tt) ((((tt) >= cur - 2) ? 0.f : cb) - mref + (NSA_LANEOK(tt) ? 0.f : NEG_INF))
            int sidx = 0;
#pragma unroll 1
            for (;;) {
                int tc = -1, td = -1;
                if (rem) { tc = __builtin_ctz(rem); rem &= rem - 1u; if (rem) { td = __builtin_ctz(rem); rem &= rem - 1u; } }
                if (tc >= 0) { const int tdd = td >= 0 ? td : tc;
                    kA = *(const u32x4*)(kgp + (size_t)tc * (64 * 256)); vA = *(const u32x4*)(vgp + tc * 64);
                    kB = *(const u32x4*)(kgp + (size_t)tdd * (64 * 256)); vB = *(const u32x4*)(vgp + tdd * 64); }
                const int po = (sidx & 1) * (2 * 9216), pn = (2 * 9216) - po;
                const bool two = tb >= 0;
                f32x16 a0, a1, b0, b1;
                {
                    bf16x8 kfa[8], kfb[8];
                    lds_frag8<32 * 144>(kfa, kra + po);
                    lds_wait8(kfa);
                    qk_frags(a0, a1, kfa, qf, NSA_INIT(ta));
                    lds_frag8<32 * 144>(kfb, kra + po + 9216);
                    lds_wait8(kfb);
                    if (two) qk_frags(b0, b1, kfb, qf, NSA_INIT(tb));
                }
                {
                    const int D0 = t - 64 * ta - 4 * hi;
                    if (ta >= cur - 2) near_bias(a0, a1, D0, luth);
                    else if (br && ta == cur - 8) far_mask(a0, a1, D0, 512);
                }
                if (two) {
                    const int D0 = t - 64 * tb - 4 * hi;
                    if (tb >= cur - 2) near_bias(b0, b1, D0, luth);
                    else if (br && tb == cur - 8) far_mask(b0, b1, D0, 512);
                }
                if (sidx == 0) softmax_decide2<2>(a0, a1, b0, b1, two, mref, l, seen, o);
                float lstep = 0.f;
                bf16x8 vfa[8], vfb[8];
                lds_frag8<32 * 144>(vfa, vra + po);
                softmax_exp(a0, a1, lstep);
                if (two) softmax_exp(b0, b1, lstep);
                l += lstep;
                lds_wait8(vfa);
#pragma unroll
                for (int ks = 0; ks < 4; ++ks) { const bf16x8 pb = pack8(ks < 2 ? a0 : a1, 8 * (ks & 1)); o[0] = MFMA32(vfa[2 * ks], pb, o[0]); o[1] = MFMA32(vfa[2 * ks + 1], pb, o[1]); }
                lds_frag8<32 * 144>(vfb, vra + po + 9216);
                lds_wait8(vfb);
                if (two) {
#pragma unroll
                    for (int ks = 0; ks < 4; ++ks) { const bf16x8 pb = pack8(ks < 2 ? b0 : b1, 8 * (ks & 1)); o[0] = MFMA32(vfb[2 * ks], pb, o[0]); o[1] = MFMA32(vfb[2 * ks + 1], pb, o[1]); }
                }
                if (tc >= 0) { *(LAS u32x4*)(kst + pn) = kA; *(LAS u32x4*)(kst + pn + 9216) = kB; *(LAS u32x4*)(vst + pn) = vA; *(LAS u32x4*)(vst + pn + 9216) = vB; }
                if (sidx != 0) (void)ref_move<2>(lstep, mref, l, o);
                __syncthreads();
                if (tc < 0) break;
                ta = tc; tb = td; ++sidx;
            }
#undef NSA_LANEOK
#undef NSA_INIT
            l = xhalf_sum(l);
            const float sc = (br ? g2 : g1) / l;
            if (br == 0) {
#pragma unroll
                for (int dt = 0; dt < 2; ++dt)
#pragma unroll
                    for (int r = 0; r < 16; r += 2) { const unsigned w = ACCL[(dt * 8 + (r >> 1)) * 64]; ACCL[(dt * 8 + (r >> 1)) * 64] = cvtpk(bf2f(w & 0xffffu) + o[dt][r] * sc, bf2f(w >> 16) + o[dt][r + 1] * sc); }
            } else {
                LAS unsigned char* stg = lds + NL_VT + wid * (32 * 144);
                u32x4 zz[4];
#pragma unroll
                for (int i = 0; i < 4; ++i) zz[i] = *(const u32x4*)(SZ + (rowb + start + 32 * th + i * 8 + (lane >> 3)) * DM + head * 64 + (lane & 7) * 8);
#pragma unroll
                for (int dt = 0; dt < 2; ++dt)
#pragma unroll
                    for (int aa = 0; aa < 4; ++aa) {
                        const unsigned wa = ACCL[(dt * 8 + 2 * aa) * 64], wb = ACCL[(dt * 8 + 2 * aa + 1) * 64];
                        const float f0 = bf2f(wa & 0xffffu) + o[dt][4 * aa] * sc, f1 = bf2f(wa >> 16) + o[dt][4 * aa + 1] * sc, f2 = bf2f(wb & 0xffffu) + o[dt][4 * aa + 2] * sc, f3 = bf2f(wb >> 16) + o[dt][4 * aa + 3] * sc;
                        *(LAS u32x2*)(stg + r32 * 144 + (32 * dt + 8 * aa + 4 * hi) * 2) = (u32x2){cvtpk(f0, f1), cvtpk(f2, f3)}; }
                LDS_WAIT(); asm volatile("" ::: "memory");
#pragma unroll
                for (int i = 0; i < 4; ++i) { const int row = i * 8 + (lane >> 3), chn = lane & 7;
                    const size_t off = (rowb + start + 32 * th + row) * DM + head * 64 + chn * 8;
                    const u32x4 v = *(const LAS u32x4*)(stg + row * 144 + chn * 16), z = zz[i];
                    u32x4 w;
                    w.x = cvtpk(bf2f(v.x & 0xffffu) * bf2f(z.x & 0xffffu), bf2f(v.x >> 16) * bf2f(z.x >> 16)); w.y = cvtpk(bf2f(v.y & 0xffffu) * bf2f(z.y & 0xffffu), bf2f(v.y >> 16) * bf2f(z.y >> 16));
                    w.z = cvtpk(bf2f(v.z & 0xffffu) * bf2f(z.z & 0xffffu), bf2f(v.z >> 16) * bf2f(z.z >> 16)); w.w = cvtpk(bf2f(v.w & 0xffffu) * bf2f(z.w & 0xffffu), bf2f(v.w >> 16) * bf2f(z.w >> 16));
                    pg8::st16_wt(O0 + off, w); }
            }
        }
    }
}

constexpr int DL_LUT = 0, DL_KT = 16 * LUTN * 4, DL_VT = DL_KT + 2 * 64 * 272, DL_SUB = DL_VT + 2 * 128 * 144, DL_END = DL_SUB + 1024 * 4, DL_X = DL_KT;
static_assert(DL_END <= 131072 && DL_END - DL_X >= 65536, "diff lds");
__device__ __forceinline__ void diff_phase(const Ctx& C, const Args& a) {
    unsigned char* ws = a.ws;
    LAS unsigned char* lds = C.lds;
    LAS float* LUT = (LAS float*)(lds + DL_LUT);
    { u32x4 lv[3];
#pragma unroll
      for (int i = 0; i < 3; ++i) { const int idx = C.tid + NTHREADS * i; lv[i] = (idx < 16 * LUTN / 4) ? ((const u32x4*)(ws + WS_LUT))[idx] : (u32x4){}; }
#pragma unroll
      for (int i = 0; i < 3; ++i) { const int idx = C.tid + NTHREADS * i; if (idx < 16 * LUTN / 4) ((LAS u32x4*)LUT)[idx] = lv[i]; } }
    const bf16_t* Q1 = (const bf16_t*)(ws + WS_R1);
    const bf16_t* K1 = (const bf16_t*)(ws + WS_R2);
    const bf16_t* V1T = (const bf16_t*)(ws + WS_R3);
    const bf16_t* SZ = (const bf16_t*)(ws + WS_R4);
    bf16_t* O1 = (bf16_t*)(ws + WS_R0);
    const float lam = *(const float*)(ws + WS_LAM);
    const float* subln = a.in[17];
    if (C.tid < 256) ((LAS f32x4*)(lds + DL_SUB))[C.tid] = ((const f32x4*)subln)[C.tid];
    __syncthreads();
    for (int it = 0;; ++it) {
        int bh, qblk;
        if (C.G == 256) { if (it >= 8) break; const int x = C.vcu >> 5, c = C.vcu & 31, cc = c & 15; bh = x * 16 + (it >> 1) * 4 + 2 * (c >> 4) + (it & 1); qblk = (it & 1) ? 15 - cc : cc; }
        else { const int u = C.vcu + it * C.G; if (u >= 2048) break; bh = u >> 4; qblk = u & 15; }
        int tid = C.tid; asm volatile("" : "+v"(tid));
        const int lane = tid & 63, wid = __builtin_amdgcn_readfirstlane(tid >> 6), r32 = lane & 31, hi = lane >> 5, mp = wid >> 2, sb = wid & 3;
        const int b = bh >> 3, h = bh & 7, start = qblk * 128;
        const size_t rowb = (size_t)b * SEQ;
        const int qlo = start + 32 * sb, t = qlo + r32;
        const LAS float* luth = LUT + (2 * h + mp) * LUTN + LPAD;
        const float cb = luth[127];
        bf16x8 qf[4];
        { const bf16_t* qp = Q1 + (rowb + t) * DM + h * 128 + mp * 64 + 8 * hi;
#pragma unroll
          for (int ds = 0; ds < 4; ++ds) qf[ds] = *(const bf16x8*)(qp + 16 * ds); }
        const bf16_t* Kg = K1 + rowb * DM + h * 128;
        const bf16_t* Vg = V1T + ((size_t)b * DM + h * 128) * SEQ;
        const int NT = 2 * qblk + 2;
        float mref = 0.f, l = 0.f; bool seen = false; f32x16 o[4];
#pragma unroll
        for (int dt = 0; dt < 4; ++dt) o[dt] = (f32x16){};
        const bf16_t* kgp = Kg + (size_t)(tid >> 4) * DM + (tid & 15) * 8;
        const bf16_t* vgp = Vg + (size_t)(tid >> 3) * SEQ + (tid & 7) * 8;
        LAS unsigned char* kst = lds + DL_KT + (tid >> 4) * 272 + (tid & 15) * 16;
        LAS unsigned char* vst = lds + DL_VT + (tid >> 3) * 144 + (tid & 7) * 16;
        const unsigned kra = (unsigned)(uintptr_t)(lds + DL_KT + r32 * 272 + (mp * 64 + 8 * hi) * 2);
        const unsigned vra = (unsigned)(uintptr_t)(lds + DL_VT + r32 * 144 + 16 * hi);
        u32x4 kreg[2], vreg[2];
        {
            u32x4 k1r[2];
#pragma unroll
            for (int i = 0; i < 2; ++i) { kreg[i] = *(const u32x4*)(kgp + (size_t)(32 * i) * DM); vreg[i] = *(const u32x4*)(vgp + (size_t)(64 * i) * SEQ); k1r[i] = *(const u32x4*)(kgp + (size_t)(64 + 32 * i) * DM); }
#pragma unroll
            for (int i = 0; i < 2; ++i) { *(LAS u32x4*)(kst + i * 32 * 272) = kreg[i]; *(LAS u32x4*)(kst + 64 * 272 + i * 32 * 272) = k1r[i]; *(LAS u32x4*)(vst + i * 64 * 144) = vreg[i]; }
        }
        __syncthreads();
#define DF_ACTIVE(n) (64 * (n) <= qlo + 31)
#define DF_NEAR(n) ((qlo - (64 * (n) + 63)) < 113)
#define DF_INIT(n) ((DF_NEAR(n) ? 0.f : cb) - mref)
        f32x16 c0, c1, n0, n1;
        { bf16x8 kf[8]; lds_frag8<32 * 272>(kf, kra); lds_wait8(kf); qk_frags(c0, c1, kf, qf, DF_INIT(0)); }
        __syncthreads();
#pragma unroll 1
        for (int n = 0; n < NT; ++n) {
            const bool has1 = (n + 1 < NT), has2 = (n + 2 < NT);
            if (has2) {
#pragma unroll
                for (int i = 0; i < 2; ++i) kreg[i] = *(const u32x4*)(kgp + (size_t)(64 * (n + 2) + 32 * i) * DM);
            }
            if (has1) {
#pragma unroll
                for (int i = 0; i < 2; ++i) vreg[i] = *(const u32x4*)(vgp + (size_t)(64 * i) * SEQ + 64 * (n + 1));
            }
            const int cb_ = n & 1, nb_ = cb_ ^ 1;
            const bool act1 = has1 && DF_ACTIVE(n + 1);
            if (DF_ACTIVE(n)) {
                bf16x8 kf[8];
                lds_frag8<32 * 272>(kf, kra + nb_ * (64 * 272));
                const int D0 = t - 64 * n - 4 * hi;
                if (DF_NEAR(n)) near_bias(c0, c1, D0, luth);
                if (n == 0) softmax_decide<4>(c0, c1, mref, l, seen, o);
                float lstep = 0.f;
                lds_wait8(kf);
                if (act1) qk_frags(n0, n1, kf, qf, DF_INIT(n + 1));
                bf16x8 va[8];
                lds_frag8v<32 * 144>(va, vra + cb_ * (128 * 144));
                softmax_exp1(c0, lstep);
                lds_wait8(va);
                bf16x8 vb[8];
                lds_frag8v<32 * 144>(vb, vra + cb_ * (128 * 144) + 64);
#pragma unroll
                for (int ks = 0; ks < 2; ++ks) { const bf16x8 pb = pack8(c0, 8 * ks);
#pragma unroll
                    for (int dt = 0; dt < 4; ++dt) o[dt] = MFMA32(va[4 * ks + dt], pb, o[dt]); }
                softmax_exp1(c1, lstep);
                l += lstep;
                lds_wait8(vb);
#pragma unroll
                for (int ks = 0; ks < 2; ++ks) { const bf16x8 pb = pack8(c1, 8 * ks);
#pragma unroll
                    for (int dt = 0; dt < 4; ++dt) o[dt] = MFMA32(vb[4 * ks + dt], pb, o[dt]); }
                if (n != 0) { const float dlx = ref_move<4>(lstep, mref, l, o);
                    if (__any(dlx != 0.f)) {
#pragma unroll
                        for (int r = 0; r < 16; ++r) { n0[r] -= dlx; n1[r] -= dlx; } } }
            }
            if (has2) {
#pragma unroll
                for (int i = 0; i < 2; ++i) *(LAS u32x4*)(kst + cb_ * (64 * 272) + i * 32 * 272) = kreg[i];
            }
            if (has1) {
#pragma unroll
                for (int i = 0; i < 2; ++i) *(LAS u32x4*)(vst + nb_ * (128 * 144) + i * 64 * 144) = vreg[i];
            }
            __syncthreads();
            c0 = n0; c1 = n1;
        }
#undef DF_ACTIVE
#undef DF_NEAR
#undef DF_INIT
        l = xhalf_sum(l);
        const float inv = 1.0f / l;
        LAS float* X = (LAS float*)(lds + DL_X);
        if (mp == 1) {
#pragma unroll
            for (int dt = 0; dt < 4; ++dt)
#pragma unroll
                for (int r = 0; r < 16; ++r) X[((sb * 4 + dt) * 16 + r) * 64 + lane] = o[dt][r] * inv;
        }
        __syncthreads();
        if (mp == 0) {
            u32x4 zz[8];
#pragma unroll
            for (int i = 0; i < 8; ++i) zz[i] = *(const u32x4*)(SZ + (rowb + qlo + 4 * i + (lane >> 4)) * DM + h * 128 + (lane & 15) * 8);
            float ss = 0.f;
#pragma unroll
            for (int dt = 0; dt < 4; ++dt)
#pragma unroll
                for (int r = 0; r < 16; ++r) { const float av = o[dt][r] * inv - lam * X[((sb * 4 + dt) * 16 + r) * 64 + lane]; o[dt][r] = av; ss += av * av; }
            ss = xhalf_sum(ss);
            const float rs = rsqrtf(ss * (1.0f / 128.0f) + EPS) * (1.0f - LAMBDA_INIT);
            LAS unsigned char* stg = lds + DL_X + sb * 16384;
#pragma unroll
            for (int dt = 0; dt < 4; ++dt)
#pragma unroll
                for (int aa = 0; aa < 4; ++aa) { const int e = 32 * dt + 8 * aa;
                    const f32x4 sg = *(const LAS f32x4*)(lds + DL_SUB + (h * 128 + 4 * hi + e) * 4);
                    u32x2 w; w.x = cvtpk(o[dt][4 * aa] * rs * sg.x, o[dt][4 * aa + 1] * rs * sg.y); w.y = cvtpk(o[dt][4 * aa + 2] * rs * sg.z, o[dt][4 * aa + 3] * rs * sg.w);
                    *(LAS u32x2*)(stg + r32 * 272 + (4 * hi + e) * 2) = w; }
            LDS_WAIT(); asm volatile("" ::: "memory");
#pragma unroll
            for (int i = 0; i < 8; ++i) { const int row = 4 * i + (lane >> 4), chn = lane & 15;
                const u32x4 v = *(const LAS u32x4*)(stg + row * 272 + chn * 16), z = zz[i];
                u32x4 w;
                w.x = cvtpk(bf2f(v.x & 0xffffu) * bf2f(z.x & 0xffffu), bf2f(v.x >> 16) * bf2f(z.x >> 16)); w.y = cvtpk(bf2f(v.y & 0xffffu) * bf2f(z.y & 0xffffu), bf2f(v.y >> 16) * bf2f(z.y >> 16));
                w.z = cvtpk(bf2f(v.z & 0xffffu) * bf2f(z.z & 0xffffu), bf2f(v.z >> 16) * bf2f(z.z >> 16)); w.w = cvtpk(bf2f(v.w & 0xffffu) * bf2f(z.w & 0xffffu), bf2f(v.w >> 16) * bf2f(z.w >> 16));
                pg8::st16_wt(O1 + (rowb + qlo + row) * DM + h * 128 + chn * 8, w); }
        }
        __syncthreads();
    }
}

template <bool FIRST> struct RowRaw { u32x2 y[2][4]; f32x4 xf[2][4]; u32x2 xb[2][4]; };
template <bool FIRST>
__device__ __forceinline__ void row_load(RowRaw<FIRST>& R, int m0, int NGW, const bf16_t* Y, const float* xin, const bf16_t* X1b, int lane) {
    int mr[2]; mr[0] = m0; mr[1] = (m0 + NGW < MTOK) ? m0 + NGW : m0;
#pragma unroll
    for (int q = 0; q < 2; ++q) { const size_t ro = (size_t)mr[q] * DM;
#pragma unroll
        for (int jj = 0; jj < 4; ++jj) { R.y[q][jj] = ((const u32x2*)(Y + ro) + lane)[64 * jj];
            if (FIRST) R.xf[q][jj] = __builtin_nontemporal_load((const f32x4*)(xin + ro) + lane + 64 * jj);
            else R.xb[q][jj] = ((const u32x2*)(X1b + ro) + lane)[64 * jj]; } }
}
template <bool FIRST>
__device__ __forceinline__ void row_proc(const RowRaw<FIRST>& R, int m0, int NGW, bf16_t* X1b, const f32x4 (&gpo)[4], float* out, const f32x4 (&gpr)[4], bf16_t* U, int lane) {
    f32x4 y[2][4], x[2][4]; float s[2] = {0.f, 0.f};
    int mr[2]; mr[0] = m0; mr[1] = (m0 + NGW < MTOK) ? m0 + NGW : m0;
#pragma unroll
    for (int q = 0; q < 2; ++q)
#pragma unroll
        for (int jj = 0; jj < 4; ++jj) { const u32x2 w = R.y[q][jj]; y[q][jj] = (f32x4){bf2f(w.x & 0xffffu), bf2f(w.x >> 16), bf2f(w.y & 0xffffu), bf2f(w.y >> 16)};
            if (FIRST) x[q][jj] = R.xf[q][jj];
            else { const u32x2 v = R.xb[q][jj]; x[q][jj] = (f32x4){bf2f(v.x & 0xffffu), bf2f(v.x >> 16), bf2f(v.y & 0xffffu), bf2f(v.y >> 16)}; } }
#pragma unroll
    for (int q = 0; q < 2; ++q)
#pragma unroll
        for (int jj = 0; jj < 4; ++jj) s[q] += (y[q][jj].x * y[q][jj].x + y[q][jj].y * y[q][jj].y) + (y[q][jj].z * y[q][jj].z + y[q][jj].w * y[q][jj].w);
    const float r0 = rsqrtf(wave_sum(s[0]) * (1.f / DM) + EPS), r1 = rsqrtf(wave_sum(s[1]) * (1.f / DM) + EPS);
    const bool two = (m0 + NGW < MTOK);
    float s1[2] = {0.f, 0.f};
#pragma unroll
    for (int q = 0; q < 2; ++q) { const size_t ro = (size_t)mr[q] * DM; const float r = q ? r1 : r0;
        if (q == 1 && !two) continue;
#pragma unroll
        for (int jj = 0; jj < 4; ++jj) { const f32x4 gv = gpo[jj]; x[q][jj] = x[q][jj] + y[q][jj] * r * gv;
            if (FIRST) { u32x2 w; w.x = cvtpk(x[q][jj].x, x[q][jj].y); w.y = cvtpk(x[q][jj].z, x[q][jj].w); pg8::st8_wt((u32x2*)(X1b + ro) + lane + 64 * jj, w);
                x[q][jj] = (f32x4){bf2f(w.x & 0xffffu), bf2f(w.x >> 16), bf2f(w.y & 0xffffu), bf2f(w.y >> 16)}; }
            else __builtin_nontemporal_store(x[q][jj], (f32x4*)(out + ro) + lane + 64 * jj);
            s1[q] += (x[q][jj].x * x[q][jj].x + x[q][jj].y * x[q][jj].y) + (x[q][jj].z * x[q][jj].z + x[q][jj].w * x[q][jj].w); } }
    if (FIRST) {
        const float q0 = rsqrtf(wave_sum(s1[0]) * (1.f / DM) + EPS), q1 = rsqrtf(wave_sum(s1[1]) * (1.f / DM) + EPS);
#pragma unroll
        for (int q = 0; q < 2; ++q) { if (q == 1 && !two) continue;
            const float rr = q ? q1 : q0; u32x2* uo = (u32x2*)(U + (size_t)mr[q] * DM) + lane;
#pragma unroll
            for (int jj = 0; jj < 4; ++jj) { const f32x4 gv = gpr[jj]; u32x2 w; w.x = cvtpk(x[q][jj].x * rr * gv.x, x[q][jj].y * rr * gv.y); w.y = cvtpk(x[q][jj].z * rr * gv.z, x[q][jj].w * rr * gv.w); pg8::st8_wt(uo + 64 * jj, w); } }
    }
}
template <bool FIRST>
__device__ __forceinline__ void row_phase(const Ctx& C, const bf16_t* Y, const float* xin, bf16_t* X1b, const float* gpost, float* out, const float* gpre, bf16_t* U) {
    const int gw = C.vcu * NWAVES + C.wave, NGW = C.G * NWAVES, lane = C.lane;
    if (gw >= MTOK) return;
    f32x4 gpo[4], gpr[4];
#pragma unroll
    for (int jj = 0; jj < 4; ++jj) { gpo[jj] = ((const f32x4*)gpost)[lane + 64 * jj]; gpr[jj] = FIRST ? ((const f32x4*)gpre)[lane + 64 * jj] : (f32x4){0.f, 0.f, 0.f, 0.f}; }
    RowRaw<FIRST> A, B;
    row_load<FIRST>(A, gw, NGW, Y, xin, X1b, lane);
#pragma unroll 1
    for (int m0 = gw; m0 < MTOK; m0 += 4 * NGW) {
        const int m1 = m0 + 2 * NGW, m2 = m0 + 4 * NGW;
        if (m1 < MTOK) row_load<FIRST>(B, m1, NGW, Y, xin, X1b, lane);
        row_proc<FIRST>(A, m0, NGW, X1b, gpo, out, gpr, U, lane);
        if (m1 >= MTOK) break;
        if (m2 < MTOK) row_load<FIRST>(A, m2, NGW, Y, xin, X1b, lane);
        row_proc<FIRST>(B, m1, NGW, X1b, gpo, out, gpr, U, lane);
    }
}

#define XB_TMO      128
#define XB_XCNT(j)  (256  + 64 * (j))
#define XB_XSUB(j)  (1280 + 64 * (j))
#define XB_XGEN(j)  (2304 + 64 * (j))
#define XB_TOP      3328
#define XB_TOPGEN   3392
#define XCD_BAR_WORDS 3456
#define XB_SPIN_CAP (1u << 18)

__device__ __forceinline__ unsigned xb_ld(unsigned* p)              { return __hip_atomic_load(p, __ATOMIC_RELAXED, __HIP_MEMORY_SCOPE_AGENT); }
__device__ __forceinline__ unsigned xb_add(unsigned* p, unsigned v) { return __hip_atomic_fetch_add(p, v, __ATOMIC_RELAXED, __HIP_MEMORY_SCOPE_AGENT); }
__device__ __forceinline__ unsigned xb_xcc_id() { return (unsigned)__builtin_amdgcn_s_getreg((3 << 11) | 20) & 0xFu; }
#define XB_SPIN(cond, bar) do { unsigned _sp = 0; while (cond) { __builtin_amdgcn_s_sleep(1); \
    if ((++_sp & 255u) == 0u) { if (xb_ld(&(bar)[XB_TMO])) break; if (_sp > XB_SPIN_CAP) { atomicAdd(&(bar)[XB_TMO], 1u); break; } } } } while (0)

struct XcdBarrier {
    unsigned* bar; unsigned x;
    volatile LAS unsigned* st;
};

__device__ __forceinline__ XcdBarrier xcd_barrier_post(unsigned* bar, volatile LAS unsigned* st) {
    XcdBarrier b; b.bar = bar; b.x = xb_xcc_id(); b.st = st;
    if (threadIdx.x == 0) (void)xb_add(&bar[XB_XCNT(b.x)], 1u);
    return b;
}
__device__ __forceinline__ void xcd_barrier_complete(unsigned* bar, unsigned x, unsigned& nloc, unsigned& nx) {
    const unsigned G = gridDim.x * gridDim.y * gridDim.z;
    unsigned sum, cnt, mine, sp = 0u;
    for (;;) {
        sum = 0u; cnt = 0u; mine = 0u;
#pragma unroll
        for (unsigned j = 0; j < 16; ++j) { const unsigned c = xb_ld(&bar[XB_XCNT(j)]); sum += c; cnt += (c > 0u) ? 1u : 0u; mine = (j == x) ? c : mine; }
        if (sum == G) break;
        __builtin_amdgcn_s_sleep(1);
        if ((++sp & 255u) == 0u) { if (xb_ld(&bar[XB_TMO])) break; if (sp > XB_SPIN_CAP) { atomicAdd(&bar[XB_TMO], 1u); break; } }
    }
    nloc = mine > 0u ? mine : 1u; nx = cnt > 0u ? cnt : 1u;
}

__device__ __forceinline__ void xcd_barrier(const XcdBarrier& b) {
    asm volatile("s_waitcnt vmcnt(0)" ::: "memory");
    __syncthreads();
    if (threadIdx.x == 0) {
        unsigned* bar = b.bar;
        __builtin_amdgcn_s_waitcnt(0);
        unsigned nloc = b.st[0], nx = b.st[1];
        if (nloc == 0u) { xcd_barrier_complete(bar, b.x, nloc, nx); b.st[0] = nloc; b.st[1] = nx; }
        const unsigned old = xb_add(&bar[XB_XSUB(b.x)], 1u);
        const unsigned gen = old / nloc;
        if (old + 1u == (gen + 1u) * nloc) {
            __builtin_amdgcn_fence(__ATOMIC_RELEASE, "agent");
            asm volatile("s_waitcnt vmcnt(0)" ::: "memory");
            const unsigned og = xb_add(&bar[XB_TOP], 1u);
            const unsigned tg = og / nx;
            if (og + 1u == (tg + 1u) * nx) xb_add(&bar[XB_TOPGEN], 1u);
            else XB_SPIN(xb_ld(&bar[XB_TOPGEN]) == tg, bar);
            __builtin_amdgcn_fence(__ATOMIC_ACQUIRE, "agent");
            xb_add(&bar[XB_XGEN(b.x)], 1u);
            asm volatile("s_waitcnt vmcnt(0)" ::: "memory");
        } else {
            XB_SPIN(xb_ld(&bar[XB_XGEN(b.x)]) == gen, bar);
            __builtin_amdgcn_fence(__ATOMIC_ACQUIRE, "agent");
            asm volatile("s_waitcnt vmcnt(0)" ::: "memory");
        }
    }
    __syncthreads();
}

#define MAKE_CTX() do { int tid_ = threadIdx.x; asm volatile("" : "+v"(tid_)); C.tid = tid_; C.lane = tid_ & 63; C.wave = __builtin_amdgcn_readfirstlane(tid_ >> 6); \
    C.G = gridDim.x; { const int bx = blockIdx.x; C.vcu = (C.G % 8 == 0) ? (bx % 8) * (C.G / 8) + bx / 8 : bx; } } while (0)
__global__ void __launch_bounds__(NTHREADS, 2) mk_fwd(Args args) {
    extern __shared__ __attribute__((aligned(16))) unsigned char lds_raw[];
    Ctx C;
    C.lds = (LAS unsigned char*)lds_raw;
    MAKE_CTX();
    unsigned char* ws = args.ws;
    const int lo = args.ph_lo, hi = args.ph_hi;
#if MK_ONE_LAUNCH
    cg::grid_group grid = cg::this_grid();
    volatile LAS unsigned* MISC = (volatile LAS unsigned*)(C.lds + LDS_MISC);
    if (C.tid < 4) MISC[C.tid] = 0u;
    __syncthreads();
    XcdBarrier xbar = xcd_barrier_post((unsigned*)(ws + WS_BAR), MISC);
#define GRID_SYNC(k) do { xcd_barrier(xbar); } while (0)
#else
#define GRID_SYNC(k) do {} while (0)
#endif
#define IN(k) (lo <= (k) && (k) < hi)
#define SEAM(k) do { if (IN(k) && IN((k) + 1)) { GRID_SYNC(k); if (PROBE_DUP == 100) GRID_SYNC(k); } } while (0)
    bf16_t* R0 = (bf16_t*)(ws + WS_R0); bf16_t* R1 = (bf16_t*)(ws + WS_R1); bf16_t* R2 = (bf16_t*)(ws + WS_R2); bf16_t* R3 = (bf16_t*)(ws + WS_R3); bf16_t* R4 = (bf16_t*)(ws + WS_R4);
    if (IN(0)) { const int reps_ = (PROBE_DUP == 0 && args.ph_hi >= 10) ? 2 : 1; _Pragma("unroll 1") for (int rep_ = 0; rep_ < reps_; ++rep_) { p0_prologue(C, args); __syncthreads(); } } SEAM(0);
    if (IN(1)) { MAKE_CTX();
        pg8::Gemm g{R0, (const bf16_t*)(ws + WS_W0T), MTOK, N0PAD, DM}; pg8::StaticOrder S; S.init(MTOK, N0PAD, C.G, (int)blockIdx.x);
        pg8::EpiMix<0> E{R1, R2, R2 + 8 * MiB, R2 + 16 * MiB, R2 + 24 * MiB, R3, R3 + 8 * MiB, R4, (float*)(ws + WS_GATE), QSCALE, C.lds + LDS_EPI};
        pg8::gemm_phase<pg8::EpiMix<0>, pg8::StaticOrder, true, true>(C.lds, g, S, E);
        { const int nwg_ = (MTOK / 256) * (N0PAD / 256), full_ = nwg_ / C.G, rem_ = nwg_ - full_ * C.G;
          const int first_ = (rem_ > 0 && rem_ < C.G) ? rem_ : 0;
          if ((int)blockIdx.x >= first_) { __syncthreads(); late_transposes(C, args, first_); } }
    } SEAM(1);
    if (IN(2)) { MAKE_CTX(); const int reps_ = (PROBE_DUP == 2 && args.ph_hi >= 10) ? 2 : 1; _Pragma("unroll 1") for (int rep_ = 0; rep_ < reps_; ++rep_) { compress_phase(C, args); __syncthreads(); } } SEAM(2);
    if (IN(3)) { MAKE_CTX(); const int reps_ = (PROBE_DUP == 3 && args.ph_hi >= 10) ? 2 : 1; _Pragma("unroll 1") for (int rep_ = 0; rep_ < reps_; ++rep_) { nsa_phase(C, args); __syncthreads(); } } SEAM(3);
    if (IN(4)) { MAKE_CTX();
        pg8::Gemm g{R0, (const bf16_t*)(ws + WS_WO0T), MTOK, DM, DM}; pg8::StaticOrder S; S.init(MTOK, DM, C.G, (int)blockIdx.x);
        pg8::EpiMix<2> E{R1, nullptr, nullptr, nullptr, nullptr, nullptr, nullptr, nullptr, nullptr, 1.f, C.lds + LDS_EPI};
        pg8::gemm_phase<pg8::EpiMix<2>, pg8::StaticOrder, true, true>(C.lds, g, S, E);
    } SEAM(4);
    if (IN(5)) { MAKE_CTX(); row_phase<true>(C, R1, args.in[0], (bf16_t*)(ws + WS_X1B), args.in[3], nullptr, args.in[2] + DM, R0); } SEAM(5);
    if (IN(6)) { MAKE_CTX();
        pg8::Gemm g{R0, (const bf16_t*)(ws + WS_WDT), MTOK, N1, DM}; pg8::StaticOrder S; S.init(MTOK, N1, C.G, (int)blockIdx.x);
        pg8::EpiMix<1> E{R1, R2, nullptr, nullptr, R3, nullptr, nullptr, R4, nullptr, QSCALE, C.lds + LDS_EPI};
        pg8::gemm_phase<pg8::EpiMix<1>, pg8::StaticOrder, true, true>(C.lds, g, S, E);
    } SEAM(6);
    if (IN(7)) { MAKE_CTX(); const int reps_ = (PROBE_DUP == 7 && args.ph_hi >= 10) ? 2 : 1; _Pragma("unroll 1") for (int rep_ = 0; rep_ < reps_; ++rep_) { diff_phase(C, args); __syncthreads(); } } SEAM(7);
    if (IN(8)) { MAKE_CTX();
        pg8::Gemm g{R0, (const bf16_t*)(ws + WS_WO1T), MTOK, DM, DM}; pg8::StaticOrder S; S.init(MTOK, DM, C.G, (int)blockIdx.x);
        pg8::EpiMix<2> E{R1, nullptr, nullptr, nullptr, nullptr, nullptr, nullptr, nullptr, nullptr, 1.f, C.lds + LDS_EPI};
        pg8::gemm_phase<pg8::EpiMix<2>, pg8::StaticOrder, true, true>(C.lds, g, S, E);
    } SEAM(8);
    if (IN(9)) { MAKE_CTX(); row_phase<false>(C, R1, nullptr, (bf16_t*)(ws + WS_X1B), args.in[3] + DM, args.out, nullptr, nullptr); }
}

extern "C" void kernel_launch(void* const* d_in, const int* in_sizes, int n_in, void* d_out, int out_size, void* d_ws, size_t ws_size, hipStream_t stream) {
    static int grid = 0;
    if (grid == 0) {
        if (n_in != 19 || out_size != MTOK * DM || ws_size < WS_END) { fprintf(stderr, "kernel_launch: unexpected shapes n_in %d out %d ws %zu\n", n_in, out_size, ws_size); grid = -1; return; }
        int dev = 0, cus = 0, per_cu = 0;
        if (hipGetDevice(&dev) != hipSuccess || hipDeviceGetAttribute(&cus, hipDeviceAttributeMultiprocessorCount, dev) != hipSuccess) { grid = -1; return; }
        if (hipFuncSetAttribute((const void*)mk_fwd, hipFuncAttributeMaxDynamicSharedMemorySize, LDS_BYTES) != hipSuccess) { fprintf(stderr, "kernel_launch: hipFuncSetAttribute failed\n"); grid = -1; return; }
        if (hipOccupancyMaxActiveBlocksPerMultiprocessor(&per_cu, (const void*)mk_fwd, NTHREADS, LDS_BYTES) != hipSuccess || per_cu < 1) { fprintf(stderr, "kernel_launch: occupancy query says %d\n", per_cu); grid = -1; return; }
        grid = cus;
    }
    if (grid < 0) return;
    if (hipMemsetAsync((char*)d_ws + WS_BAR, 0, WS_BAR_BYTES, stream) != hipSuccess) { fprintf(stderr, "kernel_launch: memset failed\n"); return; }
    Args a{};
    for (int i = 0; i < 19; ++i) a.in[i] = (const float*)d_in[i];
    a.out = (float*)d_out; a.ws = (unsigned char*)d_ws;
#if MK_ONE_LAUNCH
    a.ph_lo = 0; a.ph_hi = 10;
    void* kargs[] = {&a};
    hipError_t e = hipLaunchCooperativeKernel((const void*)mk_fwd, dim3(grid), dim3(NTHREADS), kargs, LDS_BYTES, stream);
    if (e != hipSuccess) fprintf(stderr, "kernel_launch: cooperative launch failed: %s\n", hipGetErrorString(e));
#else
    for (int p = 0; p < 10; ++p) { a.ph_lo = p; a.ph_hi = p + 1; hipLaunchKernelGGL(mk_fwd, dim3(grid), dim3(NTHREADS), LDS_BYTES, stream, a); }
#endif
}
```

```cpp
#include <hip/hip_runtime.h>
#include <hip/hip_cooperative_groups.h>
#include <cstdio>
#include <cstdint>
namespace cg = cooperative_groups;

#ifndef PROBE_DUP
#define PROBE_DUP -1
#endif
#ifndef MK_ONE_LAUNCH
#define MK_ONE_LAUNCH 1
#endif

namespace pg8 {
#define PG8_LAS __attribute__((address_space(3)))
typedef unsigned short bf16_t;
typedef short bf16x8 __attribute__((ext_vector_type(8)));
typedef float f32x4 __attribute__((ext_vector_type(4)));
typedef unsigned u32x4 __attribute__((ext_vector_type(4)));
constexpr int BM = 256, BK = 64, HALF = 128, HTB = HALF * BK * 2  , STAGE_BYTES = 8 * HTB, NXCD = 8, WGM = 8;

__host__ __device__ __forceinline__ int lds_byte(int r, int c) { const int st = (r >> 4) * 2 + (c >> 5), rr = r & 15, cc = c & 31, ob = rr * 64 + cc * 2; return st * 1024 + (ob ^ (((ob >> 9) & 1) << 5)); }
__host__ __device__ __forceinline__ void stage_rc(int b, int& R, int& C) { const int st = b / 1024, sb = b % 1024, swz = sb ^ (((sb >> 9) & 1) << 5); R = (st >> 1) * 16 + swz / 64; C = (st & 1) * 32 + (swz % 64) / 2; }
__host__ __device__ __forceinline__ int perm32(int rho) { const int n = rho >> 4, i = rho & 15; return 8 * (i >> 2) + 4 * n + (i & 3); }

struct Unit { int pm, pn; };
struct Gemm { const bf16_t* A; const bf16_t* Bt; int M, N, K; };

struct StaticOrder {
    int nM, nN, nwg, G, c;
    __host__ __device__ void init(int M, int N, int G_, int c_) { nM = M / BM; nN = N / BM; nwg = nM * nN; G = G_; c = c_; }
    __host__ __device__ bool next(int i, Unit& u) const {
        const long L = (long)i * G + c; if (L >= nwg) return false;
        int wgid = (int)L; { const int q = nwg / NXCD, r = nwg % NXCD, xcd = wgid % NXCD, off = wgid / NXCD; wgid = (xcd < r ? xcd * (q + 1) : r * (q + 1) + (xcd - r) * q) + off; }
        const int nig = WGM * nN, gid = wgid / nig, fm = gid * WGM, gsz = (nM - fm) < WGM ? (nM - fm) : WGM;
        u.pm = fm + ((wgid % nig) % gsz); u.pn = (wgid % nig) / gsz; return true;
    }
    __device__ __forceinline__ void a_ready(const Unit&) const {}
    __device__ __forceinline__ void done(const Unit&) const {}
};


typedef int i32x4f __attribute__((ext_vector_type(4))); typedef int i32x8f __attribute__((ext_vector_type(8)));
typedef float f32x2_t __attribute__((ext_vector_type(2))); typedef __bf16 bf16x2_t __attribute__((ext_vector_type(2)));
__device__ __forceinline__ unsigned cvtpk(float lo, float hi) { f32x2_t v = {lo, hi}; bf16x2_t b = __builtin_convertvector(v, bf16x2_t); return __builtin_bit_cast(unsigned, b); }
typedef unsigned u32x2w __attribute__((ext_vector_type(2)));
__device__ __forceinline__ void st4_wt(void* p, unsigned v) { asm volatile("global_store_dword %0, %1, off sc1\n\ts_nop 1" :: "v"(p), "v"(v) : "memory"); }
__device__ __forceinline__ void st8_wt(void* p, u32x2w v) { asm volatile("global_store_dwordx2 %0, %1, off sc1\n\ts_nop 1" :: "v"(p), "v"(v) : "memory"); }
__device__ __forceinline__ unsigned cvt4_fp8(float a, float b, float c, float d) { int w = __builtin_amdgcn_cvt_pk_fp8_f32(a, b, 0, false); w = __builtin_amdgcn_cvt_pk_fp8_f32(c, d, w, true); return (unsigned)w; }
__device__ __forceinline__ void st16_wt(void* p, u32x4 v) { asm volatile("global_store_dwordx4 %0, %1, off sc1\n\ts_nop 1" :: "v"(p), "v"(v) : "memory"); }
__device__ __forceinline__ float silu_f(float v) { return v * __builtin_amdgcn_rcpf(1.0f + __builtin_amdgcn_exp2f(-1.4426950408889634f * v)); }
__device__ __forceinline__ float sigm_f(float v) { return __builtin_amdgcn_rcpf(1.0f + __builtin_amdgcn_exp2f(-1.4426950408889634f * v)); }

constexpr int SEQ_ = 2048;
constexpr int EPI_RS = 80, EPI_WS = 32 * EPI_RS;
template <int LAYER> struct EpiMix {
    static constexpr bool PERM = true, AFTER_DRAIN = false;
    bf16_t *Q, *KC, *VC, *KS, *VST, *KW, *VWT, *SZ; float* GATE; float qscale; PG8_LAS unsigned char* epl; float osc;
    __device__ __forceinline__ void operator()(const f32x4 (&acc)[2][2][4][2], const Unit& u, int wr, int wc, int fr, int fq) const {
        const int pn = u.pn;
        const int row0 = u.pm * BM + wr * 64 + fr, cin = wc * 32 + 8 * fq;
        int kind = 0, ld = 1024, coloff = 0, act = 0; float sc = 1.f; bf16_t* dst = Q; int nfeat = 256, featoff = 0;
        if (LAYER == 0) {
            if (pn < 4) { dst = Q; ld = 1024; coloff = pn * 256; sc = qscale; }
            else if (pn == 4) { dst = KC; ld = 256; }
            else if (pn == 5) { dst = VC; ld = 256; }
            else if (pn == 6) { dst = KS; ld = 256; }
            else if (pn == 7) { kind = 1; dst = VST; nfeat = 256; }
            else if (pn == 8) { dst = KW; ld = 256; }
            else if (pn == 9) { kind = 1; dst = VWT; nfeat = 256; }
            else if (pn < 14) { dst = SZ; ld = 1024; coloff = (pn - 10) * 256; act = 1; }
            else kind = 2;
        } else if (LAYER == 1) {
            if (pn < 4) { dst = Q; coloff = pn * 256; sc = qscale; }
            else if (pn < 8) { dst = KC; coloff = (pn - 4) * 256; }
            else if (pn < 12) { kind = 1; dst = VST; nfeat = 1024; featoff = (pn - 8) * 256; }
            else { dst = SZ; coloff = (pn - 12) * 256; act = 1; }
        } else { dst = Q; coloff = pn * 256; sc = qscale; }
        if (kind == 1) {
            const int lane_ = (int)(threadIdx.x & 63);
            PG8_LAS unsigned char* stg = epl + (wr * 4 + wc) * EPI_WS;
            const int frp = (fr & 3) | ((fr & 4) << 1) | ((fr & 8) >> 1), par = fr & 1;
            const unsigned sel = par ? 0x03020706u : 0x05040100u;
            PG8_LAS unsigned* wp = (PG8_LAS unsigned*)(stg + (8 * fq + par) * EPI_RS) + (frp >> 1);
#pragma unroll
            for (int ai = 0; ai < 2; ++ai) {
                const int R = u.pm * BM + ai * HALF + wr * 64, b = R / SEQ_, tb = R % SEQ_;
#pragma unroll
                for (int bj = 0; bj < 2; ++bj) {
                    bf16_t* gbase = dst + ((size_t)b * nfeat + featoff + wc * 32 + bj * HALF) * SEQ_ + tb;
#pragma unroll
                    for (int mp = 0; mp < 2; ++mp) {
#pragma unroll
                        for (int mq = 0; mq < 2; ++mq) {
                            const f32x4 v0 = acc[ai][bj][2 * mp + mq][0] * osc, v1 = acc[ai][bj][2 * mp + mq][1] * osc;
                            unsigned w[4]; w[0] = cvtpk(v0[0], v0[1]); w[1] = cvtpk(v0[2], v0[3]); w[2] = cvtpk(v1[0], v1[1]); w[3] = cvtpk(v1[2], v1[3]);
#pragma unroll
                            for (int k = 0; k < 4; ++k) { const unsigned pw = (unsigned)__builtin_amdgcn_update_dpp(0, (int)w[k], 0xB1, 0xf, 0xf, true);
                                wp[(2 * k * EPI_RS) / 4 + mq * 8] = __builtin_amdgcn_perm(pw, w[k], sel); }
                        }
                        asm volatile("s_waitcnt lgkmcnt(0)" ::: "memory");
#pragma unroll
                        for (int i = 0; i < 2; ++i) { const int idx = lane_ + 64 * i, f = idx >> 2, q4 = idx & 3;
                            const u32x4 o = *(const PG8_LAS u32x4*)(stg + f * EPI_RS + q4 * 16);
                            st16_wt(gbase + (size_t)f * SEQ_ + 32 * mp + 8 * q4, o); }
                    }
                }
            }
            return;
        }
#pragma unroll
        for (int ai = 0; ai < 2; ++ai)
#pragma unroll
            for (int m = 0; m < 4; ++m) {
                const int row = row0 + ai * HALF + m * 16;
#pragma unroll
                for (int bj = 0; bj < 2; ++bj) {
                    f32x4 v0 = acc[ai][bj][m][0], v1 = acc[ai][bj][m][1];
                    if (LAYER == 1) { v0 = v0 * osc; v1 = v1 * osc; }
                    const int c = cin + bj * HALF;
                    if (kind == 0) {
                        if (act == 1) {
#pragma unroll
                            for (int e = 0; e < 4; ++e) { v0[e] = silu_f(v0[e]); v1[e] = silu_f(v1[e]); }
                        }
                        v0 = v0 * sc; v1 = v1 * sc;
                        if (LAYER == 0 && (pn == 6 || pn == 8)) {
                            const int ch = (c & 63) >> 3;
                            u32x2w w8; w8.x = cvt4_fp8(v0[0] * 4.0f, v0[1] * 4.0f, v0[2] * 4.0f, v0[3] * 4.0f); w8.y = cvt4_fp8(v1[0] * 4.0f, v1[1] * 4.0f, v1[2] * 4.0f, v1[3] * 4.0f);
                            st8_wt((unsigned char*)dst + (size_t)row * 256 + (c & ~63) + 8 * (4 * (ch & 1) + (ch >> 1)), w8);
                            continue; }
                        if (LAYER == 1 && pn < 8) {
                            const float f8s = pn < 4 ? 16.0f : 4.0f;
                            u32x2w w8; w8.x = cvt4_fp8(v0[0] * f8s, v0[1] * f8s, v0[2] * f8s, v0[3] * f8s); w8.y = cvt4_fp8(v1[0] * f8s, v1[1] * f8s, v1[2] * f8s, v1[3] * f8s);
                            st8_wt((unsigned char*)dst + (size_t)row * ld + coloff + c, w8);
                            continue; }
                        u32x4 w; w.x = cvtpk(v0[0], v0[1]); w.y = cvtpk(v0[2], v0[3]); w.z = cvtpk(v1[0], v1[1]); w.w = cvtpk(v1[2], v1[3]);
                        if (act == 1) __builtin_nontemporal_store(w, (u32x4*)(dst + (size_t)row * ld + coloff + c)); else st16_wt(dst + (size_t)row * ld + coloff + c, w);
                    } else {
                        if (c < 48) {
                            f32x4 g0, g1;
#pragma unroll
                            for (int e = 0; e < 4; ++e) { g0[e] = sigm_f(v0[e]); g1[e] = sigm_f(v1[e]); }
                            float* gp = GATE + (size_t)row * 48 + c;
                            *(f32x4*)gp = g0; *(f32x4*)(gp + 4) = g1;
                        }
                    }
                }
            }
    }
};

template <class Epi, class Sched, bool ALIGN_EPI = false, bool SP2 = false, bool F8 = false>
__device__ __forceinline__ void gemm_phase(PG8_LAS unsigned char* lds, const Gemm g, const Sched& S, const Epi& E) {
    const int tid = threadIdx.x, wid = __builtin_amdgcn_readfirstlane(tid >> 6), lane = tid & 63, wr = wid >> 2, wc = wid & 3, fr = lane & 15, fq = lane >> 4;
    const int K = g.K, nt = K / BK;
    unsigned voffA[2], voffB[2];
#pragma unroll
    for (int i = 0; i < 2; ++i) { int R, C; stage_rc(tid * 16 + i * 8192, R, C); const int Rb = Epi::PERM ? ((R & ~31) + perm32(R & 31)) : R;
        voffA[i] = (unsigned)(R * K + C) * 2u; voffB[i] = (unsigned)(Rb * K + C) * 2u; }
    const size_t kstep = (size_t)(BK * 2);
    const size_t hstep = (size_t)HALF * K * 2;
    const size_t tstep = 2 * hstep;
    const unsigned ldsw = (unsigned)wid * 1024u;
    const int aoff = lds_byte(wr * 64 + fr, fq * 8), boff = lds_byte(wc * 32 + fr, fq * 8);
#define PG8_SA(b, h) (((b) * 2 + (h)) * HTB)
#define PG8_SB(b, h) ((4 + (b) * 2 + (h)) * HTB)
#define PG8_STAGE(bufoff, gbase, voff) do { _Pragma("unroll") for (int _i = 0; _i < 2; ++_i) \
        __builtin_amdgcn_global_load_lds((const unsigned*)((const char*)(gbase) + (voff)[_i]), (PG8_LAS unsigned*)(lds + (bufoff) + ldsw + _i * 8192), 16, 0, 0); } while (0)
#define PG8_LDA(dst, b, h) do { if constexpr (F8) { _Pragma("unroll") for (int m = 0; m < 4; ++m) { const i32x4f lo_ = *(const PG8_LAS i32x4f*)(lds + PG8_SA(b, h) + aoff + m * 2048), hi_ = *(const PG8_LAS i32x4f*)(lds + PG8_SA(b, h) + aoff + m * 2048 + 1024); \
            dst##8[m] = __builtin_shufflevector(lo_, hi_, 0, 1, 2, 3, 4, 5, 6, 7); } } \
        else { _Pragma("unroll") for (int m = 0; m < 4; ++m) _Pragma("unroll") for (int k = 0; k < 2; ++k) dst[m][k] = *(const PG8_LAS bf16x8*)(lds + PG8_SA(b, h) + aoff + m * 2048 + k * 1024); } } while (0)
#define PG8_LDB(dst, b, h) do { if constexpr (F8) { _Pragma("unroll") for (int n = 0; n < 2; ++n) { const i32x4f lo_ = *(const PG8_LAS i32x4f*)(lds + PG8_SB(b, h) + boff + n * 2048), hi_ = *(const PG8_LAS i32x4f*)(lds + PG8_SB(b, h) + boff + n * 2048 + 1024); \
            dst##8[n] = __builtin_shufflevector(lo_, hi_, 0, 1, 2, 3, 4, 5, 6, 7); } } \
        else { _Pragma("unroll") for (int n = 0; n < 2; ++n) _Pragma("unroll") for (int k = 0; k < 2; ++k) dst[n][k] = *(const PG8_LAS bf16x8*)(lds + PG8_SB(b, h) + boff + n * 2048 + k * 1024); } } while (0)
#define PG8_MMA(ai, bj, At, Bt) do { __builtin_amdgcn_s_setprio(1); \
        if constexpr (F8) { _Pragma("unroll") for (int m = 0; m < 4; ++m) _Pragma("unroll") for (int n = 0; n < 2; ++n) \
            asm volatile("v_mfma_scale_f32_16x16x128_f8f6f4 %0, %1, %2, %0, %3, %3 op_sel_hi:[0,0,0]" : "+v"(acc[ai][bj][m][n]) : "v"(Bt##8[n]), "v"(At##8[m]), "v"(f8one)); } \
        else { _Pragma("unroll") for (int m = 0; m < 4; ++m) _Pragma("unroll") for (int n = 0; n < 2; ++n) _Pragma("unroll") for (int k = 0; k < 2; ++k) \
            acc[ai][bj][m][n] = __builtin_amdgcn_mfma_f32_16x16x32_bf16(Bt[n][k], At[m][k], acc[ai][bj][m][n], 0, 0, 0); } \
        __builtin_amdgcn_s_setprio(0); } while (0)
#define PG8_WAIT_V(n) asm volatile("s_waitcnt vmcnt(" #n ")" ::: "memory")
#define PG8_WAIT_L(n) asm volatile("s_waitcnt lgkmcnt(" #n ")" ::: "memory")
#define PG8_BAR __builtin_amdgcn_s_barrier()
#define PG8_SCHED __builtin_amdgcn_sched_barrier(0)
    Unit cur, nxt; int ui = 0;
    if (!S.next(0, cur)) return;
    f32x4 acc[2][2][4][2];
#pragma unroll
    for (int a = 0; a < 2; ++a)
#pragma unroll
        for (int b = 0; b < 2; ++b)
#pragma unroll
            for (int m = 0; m < 4; ++m)
#pragma unroll
                for (int n = 0; n < 2; ++n) acc[a][b][m][n] = (f32x4){0.f, 0.f, 0.f, 0.f};
    bf16x8 At[4][2], B0[2][2], B1[2][2]; i32x8f At8[4], B08[2], B18[2];
    int f8one = 0x7f7f7f7f; asm volatile("" : "+v"(f8one));
    const char* cA = (const char*)g.A + (size_t)cur.pm * tstep; const char* cB = (const char*)g.Bt + (size_t)cur.pn * tstep;
    S.a_ready(cur);
    if constexpr (SP2) {
        PG8_STAGE(PG8_SB(0, 0), cB, voffB); PG8_STAGE(PG8_SB(0, 1), cB + hstep, voffB); PG8_STAGE(PG8_SA(0, 0), cA, voffA); PG8_STAGE(PG8_SA(0, 1), cA + hstep, voffA);
        if (wr == 1) PG8_BAR;
        PG8_WAIT_V(2); PG8_BAR;
        PG8_STAGE(PG8_SB(1, 0), cB + kstep, voffB); PG8_STAGE(PG8_SA(1, 0), cA + kstep, voffA); PG8_STAGE(PG8_SB(1, 1), cB + hstep + kstep, voffB);
        PG8_WAIT_V(6); PG8_BAR;
    } else {
        PG8_STAGE(PG8_SB(0, 0), cB, voffB); PG8_STAGE(PG8_SA(0, 0), cA, voffA); PG8_STAGE(PG8_SB(0, 1), cB + hstep, voffB); PG8_STAGE(PG8_SA(0, 1), cA + hstep, voffA);
        if (wr == 1) PG8_BAR;
        PG8_WAIT_V(4); PG8_BAR;
        PG8_STAGE(PG8_SB(1, 0), cB + kstep, voffB); PG8_STAGE(PG8_SA(1, 0), cA + kstep, voffA); PG8_STAGE(PG8_SB(1, 1), cB + hstep + kstep, voffB);
        PG8_WAIT_V(6); PG8_BAR;
    }
    for (;;) {
        const bool has_next = S.next(ui + 1, nxt);
        const char* nA = has_next ? (const char*)g.A + (size_t)nxt.pm * tstep : cA; const char* nB = has_next ? (const char*)g.Bt + (size_t)nxt.pn * tstep : cB;
        for (int t = 0; t < nt; t += 2) {
            const bool last = (t == nt - 2);
            const char* a1 = cA + (size_t)(t + 1) * kstep;
            const char* a2 = last ? nA : cA + (size_t)(t + 2) * kstep; const char* b2 = last ? nB : cB + (size_t)(t + 2) * kstep;
            const char* a3 = a2 + kstep; const char* b3 = b2 + kstep;
            if (last && has_next) S.a_ready(nxt);
            if constexpr (SP2) {
            PG8_LDB(B0, 0, 0); PG8_LDB(B1, 0, 1); PG8_SCHED; PG8_LDA(At, 0, 0); PG8_STAGE(PG8_SA(1, 1), a1 + hstep, voffA);
            PG8_WAIT_V(8); PG8_WAIT_L(0); PG8_BAR; PG8_MMA(0, 0, At, B0); PG8_MMA(0, 1, At, B1); PG8_BAR; PG8_SCHED;
            PG8_LDA(At, 0, 1); PG8_STAGE(PG8_SB(0, 0), b2, voffB); PG8_STAGE(PG8_SB(0, 1), b2 + hstep, voffB); PG8_STAGE(PG8_SA(0, 0), a2, voffA);
            PG8_WAIT_V(8); PG8_WAIT_L(0); PG8_BAR; PG8_MMA(1, 0, At, B0); PG8_MMA(1, 1, At, B1); PG8_BAR; PG8_SCHED;
            PG8_LDB(B0, 1, 0); PG8_LDB(B1, 1, 1); PG8_SCHED; PG8_LDA(At, 1, 0); PG8_STAGE(PG8_SA(0, 1), a2 + hstep, voffA);
            PG8_WAIT_V(8); PG8_WAIT_L(0); PG8_BAR; PG8_MMA(0, 0, At, B0); PG8_MMA(0, 1, At, B1); PG8_BAR; PG8_SCHED;
            PG8_LDA(At, 1, 1); PG8_STAGE(PG8_SB(1, 0), b3, voffB); PG8_STAGE(PG8_SB(1, 1), b3 + hstep, voffB); PG8_STAGE(PG8_SA(1, 0), a3, voffA);
            PG8_WAIT_V(8); PG8_WAIT_L(0); PG8_BAR; PG8_MMA(1, 0, At, B0); PG8_MMA(1, 1, At, B1); PG8_BAR; PG8_SCHED;
            } else {
            PG8_LDB(B0, 0, 0); PG8_SCHED; PG8_LDA(At, 0, 0); PG8_STAGE(PG8_SA(1, 1), a1 + hstep, voffA);
            PG8_WAIT_L(8); PG8_BAR; PG8_WAIT_L(0); PG8_MMA(0, 0, At, B0); PG8_BAR; PG8_SCHED;
            PG8_LDB(B1, 0, 1); PG8_STAGE(PG8_SB(0, 0), b2, voffB);
            PG8_BAR; PG8_WAIT_L(0); PG8_MMA(0, 1, At, B1); PG8_BAR;
            PG8_LDA(At, 0, 1); PG8_STAGE(PG8_SA(0, 0), a2, voffA);
            PG8_BAR; PG8_WAIT_L(0); PG8_MMA(1, 0, At, B0); PG8_BAR; PG8_SCHED;
            PG8_STAGE(PG8_SB(0, 1), b2 + hstep, voffB);
            PG8_WAIT_V(6); PG8_BAR; PG8_MMA(1, 1, At, B1); PG8_BAR;
            PG8_LDB(B0, 1, 0); PG8_SCHED; PG8_LDA(At, 1, 0); PG8_STAGE(PG8_SA(0, 1), a2 + hstep, voffA);
            PG8_WAIT_L(8); PG8_BAR; PG8_WAIT_L(0); PG8_MMA(0, 0, At, B0); PG8_BAR; PG8_SCHED;
            PG8_LDB(B1, 1, 1); PG8_STAGE(PG8_SB(1, 0), b3, voffB);
            PG8_BAR; PG8_WAIT_L(0); PG8_MMA(0, 1, At, B1); PG8_BAR;
            PG8_LDA(At, 1, 1); PG8_STAGE(PG8_SA(1, 0), a3, voffA);
            PG8_BAR; PG8_WAIT_L(0); PG8_MMA(1, 0, At, B0); PG8_BAR; PG8_SCHED;
            PG8_STAGE(PG8_SB(1, 1), b3 + hstep, voffB);
            PG8_WAIT_V(6); PG8_BAR; PG8_MMA(1, 1, At, B1); PG8_BAR;
            }
        }
        if constexpr (F8) asm volatile("s_nop 15\n\ts_nop 15" ::: "memory");
        if constexpr (ALIGN_EPI) { if (wr == 0) PG8_BAR; }
        if constexpr (!Epi::AFTER_DRAIN) { E(acc, cur, wr, wc, fr, fq); S.done(cur); }
        if (!has_next) break;
#pragma unroll
        for (int a = 0; a < 2; ++a)
#pragma unroll
            for (int b = 0; b < 2; ++b)
#pragma unroll
                for (int m = 0; m < 4; ++m)
#pragma unroll
                    for (int n = 0; n < 2; ++n) acc[a][b][m][n] = (f32x4){0.f, 0.f, 0.f, 0.f};
        cur = nxt; cA = nA; cB = nB; ++ui;
        if constexpr (ALIGN_EPI) { if (wr == 1) PG8_BAR; }
    }
    PG8_WAIT_V(0);
    if constexpr (!ALIGN_EPI) { if (wr == 0) PG8_BAR; }
    PG8_BAR;
    if constexpr (Epi::AFTER_DRAIN) { E.fused(acc, cur, wr, wc, fr, fq, lds, wid, lane); S.done(cur); }
#undef PG8_SA
#undef PG8_SB
#undef PG8_STAGE
#undef PG8_LDA
#undef PG8_LDB
#undef PG8_MMA
#undef PG8_WAIT_V
#undef PG8_WAIT_L
#undef PG8_BAR
#undef PG8_SCHED
}
}

#define LAS __attribute__((address_space(3)))
typedef unsigned short bf16_t;
typedef short bf16x8 __attribute__((ext_vector_type(8)));
typedef float f32x4 __attribute__((ext_vector_type(4)));
typedef float f32x16 __attribute__((ext_vector_type(16)));
typedef unsigned u32x4 __attribute__((ext_vector_type(4)));
typedef unsigned u32x2 __attribute__((ext_vector_type(2)));
using pg8::cvtpk;

typedef int i32x4 __attribute__((ext_vector_type(4))); typedef int i32x8 __attribute__((ext_vector_type(8)));
constexpr int NB = 16, SEQ = 2048, DM = 1024, MTOK = NB * SEQ;
constexpr int N0PAD = 3840, N1 = 4096;
constexpr float EPS = 1e-6f;
constexpr float LOG2E = 1.4426950408889634f;
constexpr float QSCALE = 0.125f * LOG2E;
constexpr float LAMBDA_INIT = 0.35550906759f;
constexpr int NWAVES = 8, NTHREADS = 512;
constexpr int LDS_BYTES = 155648;
constexpr int LDS_MISC = 131072 + 1024;
constexpr int LDS_EPI = LDS_MISC + 1024;
static_assert(LDS_EPI + 8 * pg8::EPI_WS <= LDS_BYTES, "lds");

constexpr size_t MiB = 1u << 20;
constexpr size_t WS_BAR = 65536, WS_BAR_BYTES = 16384;
constexpr int LPAD = 96, LUTN = 320;
constexpr size_t WS_LUT = 16384, WS_B1K = 12288, WS_B1V = 12800, WS_LAM = 13312;
constexpr size_t WS_W0T = 2 * MiB, WS_WO0T = 10 * MiB, WS_WDT = 12 * MiB, WS_WO1T = 20 * MiB;
constexpr size_t WS_W1KT = 22 * MiB, WS_W1VT = 22 * MiB + 512 * 1024, WS_W2KT = 23 * MiB, WS_W2VT = 23 * MiB + 65536;
constexpr size_t WS_KCMP = 24 * MiB, WS_VCMPT = 25 * MiB, WS_GATE = 26 * MiB;
constexpr size_t WS_R0 = 32 * MiB, WS_R1 = 96 * MiB, WS_R2 = 160 * MiB, WS_R3 = 224 * MiB, WS_R4 = 288 * MiB, WS_X1B = 352 * MiB, WS_END = 416 * MiB;

struct Args { const float* in[19]; float* out; unsigned char* ws; int ph_lo, ph_hi; };

struct Ctx {
    LAS unsigned char* lds;
    int tid, lane, wave, vcu, G;
};

template <int CTRL> __device__ __forceinline__ float dpp_f(float v) { return __int_as_float(__builtin_amdgcn_update_dpp(0, __float_as_int(v), CTRL, 0xf, 0xf, true)); }
template <int CTRL> __device__ __forceinline__ int dpp_i(int v) { return __builtin_amdgcn_update_dpp(0, v, CTRL, 0xf, 0xf, true); }
constexpr int DPP_XOR1 = 0xB1, DPP_XOR2 = 0x4E, DPP_HALF_MIRROR = 0x141, DPP_ROW_MIRROR = 0x140;
__device__ __forceinline__ float wave_sum(float v) {
    v += dpp_f<DPP_XOR1>(v); v += dpp_f<DPP_XOR2>(v); v += dpp_f<DPP_HALF_MIRROR>(v); v += dpp_f<DPP_ROW_MIRROR>(v);
    { auto rr = __builtin_amdgcn_permlane16_swap(__float_as_uint(v), __float_as_uint(v), false, false); v = __uint_as_float(rr[0]) + __uint_as_float(rr[1]); }
    { auto rr = __builtin_amdgcn_permlane32_swap(__float_as_uint(v), __float_as_uint(v), false, false); v = __uint_as_float(rr[0]) + __uint_as_float(rr[1]); }
    return v;
}
__device__ __forceinline__ float bf2f(unsigned h) { return __uint_as_float(h << 16); }
__device__ __forceinline__ int crow(int r, int hi) { return (r & 3) + 8 * (r >> 2) + 4 * hi; }
#define LDS_WAIT() asm volatile("s_waitcnt lgkmcnt(0)" ::: "memory")

__device__ __forceinline__ void transpose_item(const float* W, int K, int Nsrc, bf16_t* WT, int nblk, int item, bool remap, LAS float* scr, int lane) {
    const int kb = item / nblk, nb = item % nblk, k0 = 64 * kb, n0 = 32 * nb;
    const int n = n0 + (lane & 31);
    int src = n; bool valid = true;
    if (remap) { if (n >= 3632) valid = false; else if (n >= 3584) src = n - 1024; else if (n >= 2560) src = n + 48; }
    float tv[32];
#pragma unroll
    for (int i = 0; i < 32; ++i) { const int kk = 2 * i + (lane >> 5); tv[i] = valid ? W[(size_t)(k0 + kk) * Nsrc + src] : 0.f; }
#pragma unroll
    for (int i = 0; i < 32; ++i) { const int kk = 2 * i + (lane >> 5); scr[kk * 33 + (lane & 31)] = tv[i]; }
    LDS_WAIT(); asm volatile("" ::: "memory");
    const int c = lane & 7;
#pragma unroll
    for (int j = 0; j < 4; ++j) { const int nn = (lane >> 3) + 8 * j; const LAS float* s = scr + (8 * c) * 33 + nn;
        u32x4 o; o.x = cvtpk(s[0 * 33], s[1 * 33]); o.y = cvtpk(s[2 * 33], s[3 * 33]); o.z = cvtpk(s[4 * 33], s[5 * 33]); o.w = cvtpk(s[6 * 33], s[7 * 33]);
        *(u32x4*)(WT + (size_t)(n0 + nn) * K + k0 + 8 * c) = o; }
    LDS_WAIT(); asm volatile("" ::: "memory");
}
constexpr float F8_WSCALE = 64.0f, F8_ASCALE = 4.0f, F8_USCALE = 8.0f;
__device__ __forceinline__ void transpose_item_f8(const float* W, int K, int Nsrc, unsigned char* WT, int nblk, int item, LAS float* scr, int lane) {
    const int kb = item / nblk, nb = item % nblk, k0 = 64 * kb, n0 = 32 * nb;
    const int n = n0 + (lane & 31);
    float tv[32];
#pragma unroll
    for (int i = 0; i < 32; ++i) { const int kk = 2 * i + (lane >> 5); tv[i] = W[(size_t)(k0 + kk) * Nsrc + n]; }
#pragma unroll
    for (int i = 0; i < 32; ++i) { const int kk = 2 * i + (lane >> 5); scr[kk * 33 + (lane & 31)] = tv[i]; }
    LDS_WAIT(); asm volatile("" ::: "memory");
    const int c = lane & 7;
#pragma unroll
    for (int j = 0; j < 4; ++j) { const int nn = (lane >> 3) + 8 * j; const LAS float* sp = scr + (8 * c) * 33 + nn;
        u32x2 o; o.x = pg8::cvt4_fp8(sp[0 * 33] * F8_WSCALE, sp[1 * 33] * F8_WSCALE, sp[2 * 33] * F8_WSCALE, sp[3 * 33] * F8_WSCALE);
        o.y = pg8::cvt4_fp8(sp[4 * 33] * F8_WSCALE, sp[5 * 33] * F8_WSCALE, sp[6 * 33] * F8_WSCALE, sp[7 * 33] * F8_WSCALE);
        *(u32x2*)(WT + (size_t)(n0 + nn) * K + k0 + 8 * c) = o; }
    LDS_WAIT(); asm volatile("" ::: "memory");
}
__device__ __forceinline__ void rms_row_to_bf16(const float* xrow, const float* g, bf16_t* orow, int lane) {
    const f32x4* xr = (const f32x4*)xrow + lane; const f32x4* gr = (const f32x4*)g + lane;
    f32x4 v[4]; float s = 0.f;
#pragma unroll
    for (int j = 0; j < 4; ++j) { v[j] = xr[64 * j]; s += (v[j].x * v[j].x + v[j].y * v[j].y) + (v[j].z * v[j].z + v[j].w * v[j].w); }
    const float r = rsqrtf(wave_sum(s) * (1.f / DM) + EPS);
    u32x2* o8 = (u32x2*)orow + lane;
#pragma unroll
    for (int j = 0; j < 4; ++j) { const f32x4 gv = gr[64 * j]; u32x2 w; w.x = cvtpk(v[j].x * r * gv.x, v[j].y * r * gv.y); w.y = cvtpk(v[j].z * r * gv.z, v[j].w * r * gv.w); o8[64 * j] = w; }
}
__device__ __forceinline__ int rel_bucket(int n) {
    if (n < 16) return n;
    int lg = 16 + (int)(logf((float)n / 16.0f) / 2.0794415416798357f * 16.0f);
    return lg < 31 ? lg : 31;
}
__device__ __forceinline__ void p0_small_jobs(const Ctx& C, const Args& a, int j0, int jstride) {
    unsigned char* ws = a.ws;
    LAS float* scr = (LAS float*)(C.lds + C.wave * 16384);
    constexpr int I_W1 = 32 * 4, I_W2 = 2 * 2, NT = 2 * I_W1 + 2 * I_W2;
    for (int j = j0; j < NT + 256 + 16 * LUTN / 64 + 1; j += jstride) {
        int r = j;
        if (r < NT) {
            if (r < I_W1) { transpose_item(a.in[6], 2048, 128, (bf16_t*)(ws + WS_W1KT), 4, r, false, scr, C.lane); continue; } r -= I_W1;
            if (r < I_W1) { transpose_item(a.in[9], 2048, 128, (bf16_t*)(ws + WS_W1VT), 4, r, false, scr, C.lane); continue; } r -= I_W1;
            if (r < I_W2) { transpose_item(a.in[7], 128, 64, (bf16_t*)(ws + WS_W2KT), 2, r, false, scr, C.lane); continue; } r -= I_W2;
            transpose_item(a.in[10], 128, 64, (bf16_t*)(ws + WS_W2VT), 2, r, false, scr, C.lane); continue; }
        r -= NT;
        if (r < 256) {
            const int kv = r >> 7, n = r & 127;
            const float* pe = kv ? a.in[8] : a.in[5]; const float* w1 = kv ? a.in[9] : a.in[6];
            float s = 0.f, pv[32], wv[32];
#pragma unroll
            for (int i = 0; i < 32; ++i) { const int k = C.lane + 64 * i; pv[i] = pe[k]; wv[i] = w1[(size_t)k * 128 + n]; }
#pragma unroll
            for (int i = 0; i < 32; ++i) s += pv[i] * wv[i];
            s = wave_sum(s);
            if (C.lane == 0) ((float*)(ws + (kv ? WS_B1V : WS_B1K)))[n] = s;
            continue; }
        r -= 256;
        if (r < 16 * LUTN / 64) {
            const int idx = r * 64 + C.lane, map = idx / LUTN, dist = idx % LUTN - LPAD;
            ((float*)(ws + WS_LUT))[idx] = dist < 0 ? -INFINITY : (a.in[1][rel_bucket(dist > 127 ? 127 : dist) * 16 + map] - a.in[1][rel_bucket(127) * 16 + map]) * LOG2E;
            continue; }
        {
            const float p1 = wave_sum(a.in[13][C.lane] * a.in[14][C.lane]), p2 = wave_sum(a.in[15][C.lane] * a.in[16][C.lane]);
            if (C.lane == 0) *(float*)(ws + WS_LAM) = expf(p1) - expf(p2) + LAMBDA_INIT; }
    }
}
__device__ __forceinline__ void p0_prologue(const Ctx& C, const Args& a, bool small_here) {
    unsigned char* ws = a.ws;
    LAS float* scr = (LAS float*)(C.lds + C.wave * 16384);
    const int gw = C.vcu * NWAVES + C.wave, NGW = C.G * NWAVES;
    constexpr int I_W0 = 16 * (N0PAD / 32);
    const int gwm = C.wave * C.G + C.vcu;
    for (int it = gwm; it < I_W0; it += NGW) transpose_item(a.in[4], 1024, 3632, (bf16_t*)(ws + WS_W0T), N0PAD / 32, it, true, scr, C.lane);
    if (small_here) p0_small_jobs(C, a, (gwm + NGW - (I_W0 % NGW)) % NGW, NGW);
    bf16_t* U0 = (bf16_t*)(ws + WS_R0);
    if (gw < MTOK) {
        f32x4 va[2][4], vb[2][4], g0v[4];
        _Pragma("unroll") for (int j = 0; j < 4; ++j) g0v[j] = ((const f32x4*)a.in[2] + C.lane)[64 * j];
#define P0_LOAD(v, m) do { const int m2_ = (m) + NGW; \
        const f32x4* x0_ = (const f32x4*)(a.in[0] + (size_t)(m) * DM) + C.lane; const f32x4* x1_ = (const f32x4*)(a.in[0] + (size_t)(m2_ < MTOK ? m2_ : (m)) * DM) + C.lane; \
        _Pragma("unroll") for (int j = 0; j < 4; ++j) { v[0][j] = __builtin_nontemporal_load(x0_ + 64 * j); v[1][j] = __builtin_nontemporal_load(x1_ + 64 * j); } } while (0)
#define P0_PROC(v, m) do { const int m2_ = (m) + NGW; float s0 = 0.f, s1 = 0.f; \
        _Pragma("unroll") for (int j = 0; j < 4; ++j) { s0 += (v[0][j].x * v[0][j].x + v[0][j].y * v[0][j].y) + (v[0][j].z * v[0][j].z + v[0][j].w * v[0][j].w); s1 += (v[1][j].x * v[1][j].x + v[1][j].y * v[1][j].y) + (v[1][j].z * v[1][j].z + v[1][j].w * v[1][j].w); } \
        const float r0 = rsqrtf(wave_sum(s0) * (1.f / DM) + EPS), r1 = rsqrtf(wave_sum(s1) * (1.f / DM) + EPS); \
        u32x2* o0 = (u32x2*)(U0 + (size_t)(m) * DM) + C.lane; u32x2* o1 = (u32x2*)(U0 + (size_t)m2_ * DM) + C.lane; \
        _Pragma("unroll") for (int j = 0; j < 4; ++j) { const f32x4 gv = g0v[j]; \
            u32x2 w; w.x = cvtpk(v[0][j].x * r0 * gv.x, v[0][j].y * r0 * gv.y); w.y = cvtpk(v[0][j].z * r0 * gv.z, v[0][j].w * r0 * gv.w); pg8::st8_wt(o0 + 64 * j, w); \
            if (m2_ < MTOK) { u32x2 w1; w1.x = cvtpk(v[1][j].x * r1 * gv.x, v[1][j].y * r1 * gv.y); w1.y = cvtpk(v[1][j].z * r1 * gv.z, v[1][j].w * r1 * gv.w); pg8::st8_wt(o1 + 64 * j, w1); } } } while (0)
        P0_LOAD(va, gw);
#pragma unroll 1
        for (int m = gw; m < MTOK; m += 4 * NGW) {
            const int m1 = m + 2 * NGW, m2 = m + 4 * NGW;
            if (m1 < MTOK) P0_LOAD(vb, m1);
            P0_PROC(va, m);
            if (m1 >= MTOK) break;
            if (m2 < MTOK) P0_LOAD(va, m2);
            P0_PROC(vb, m1);
        }
#undef P0_LOAD
#undef P0_PROC
    }
}

__device__ __forceinline__ void late_transposes(const Ctx& C, const Args& a, int first) {
    unsigned char* ws = a.ws;
    LAS float* scr = (LAS float*)(C.lds + C.wave * 16384);
    const int gw = ((int)blockIdx.x - first) * NWAVES + C.wave, NGW = (C.G - first) * NWAVES;
    constexpr int I_WO = 16 * 32, I_WD = 16 * (N1 / 32);
    for (int it = gw; it < 2 * I_WO + I_WD; it += NGW) {
        int r = it;
        if (r < I_WO) { transpose_item(a.in[11], 1024, 1024, (bf16_t*)(ws + WS_WO0T), 32, r, false, scr, C.lane); continue; } r -= I_WO;
        if (r < I_WD) { transpose_item_f8(a.in[12], 1024, 4096, ws + WS_WDT, 128, r, scr, C.lane); continue; } r -= I_WD;
        transpose_item_f8(a.in[18], 1024, 1024, ws + WS_WO1T, 32, r, scr, C.lane);
    }
}

__device__ __forceinline__ void compress_phase(const Ctx& C, const Args& a) {
    unsigned char* ws = a.ws;
    const int lane = C.lane, wid = C.wave, rg = wid & 3, ch = wid >> 2, fr = lane & 15, fq = lane >> 4;
    constexpr int CST = 544;
    LAS unsigned char* AT = C.lds;
    LAS unsigned char* BT = C.lds + 64 * CST;
    LAS bf16_t* H = (LAS bf16_t*)(C.lds + 64 * CST + 128 * CST);
    const int tid = C.tid;
    for (int u = C.vcu; u < 256; u += C.G) {
        const int kv = u & 1, half = (u >> 1) & 1, bg = u >> 2, b = bg >> 2, g = bg & 3;
        const bf16_t* src = (const bf16_t*)(ws + WS_R2 + (kv ? 16 * MiB : 0)) + (size_t)b * SEQ * 256 + g * 64;
        const bf16_t* w1t = (const bf16_t*)(ws + (kv ? WS_W1VT : WS_W1KT));
        const bf16_t* w2t = (const bf16_t*)(ws + (kv ? WS_W2VT : WS_W2KT));
        const float* b1 = (const float*)(ws + (kv ? WS_B1V : WS_B1K));
        f32x4 acc[4];
#pragma unroll
        for (int nt = 0; nt < 4; ++nt) acc[nt] = (f32x4){0.f, 0.f, 0.f, 0.f};
        u32x4 ar[4], br[8];
#define CMP_LOAD(pp) do { \
        _Pragma("unroll") for (int i = 0; i < 4; ++i) { const int idx = tid + NTHREADS * i, cc = idx >> 5, l = (idx >> 3) & 3, c16 = idx & 7; int tok = 16 * (half * 64 + cc) + 4 * (pp) + l; tok = tok > SEQ - 1 ? SEQ - 1 : tok; \
            ar[i] = *(const u32x4*)(src + (size_t)tok * 256 + c16 * 8); } \
        _Pragma("unroll") for (int i = 0; i < 8; ++i) { const int idx = tid + NTHREADS * i, n = idx >> 5, ck = idx & 31; br[i] = *(const u32x4*)(w1t + (size_t)n * 2048 + 256 * (pp) + ck * 8); } } while (0)
        CMP_LOAD(0);
#pragma unroll 1
        for (int pp = 0; pp < 8; ++pp) {
            __syncthreads();
#pragma unroll
            for (int i = 0; i < 4; ++i) { const int idx = tid + NTHREADS * i, cc = idx >> 5, l = (idx >> 3) & 3, c16 = idx & 7; *(LAS u32x4*)(AT + cc * CST + l * 128 + c16 * 16) = ar[i]; }
#pragma unroll
            for (int i = 0; i < 8; ++i) { const int idx = tid + NTHREADS * i, n = idx >> 5, ck = idx & 31; *(LAS u32x4*)(BT + n * CST + ck * 16) = br[i]; }
            __syncthreads();
            if (pp + 1 < 8) CMP_LOAD(pp + 1);
#pragma unroll
            for (int ks = 0; ks < 8; ++ks) {
                const bf16x8 af = *(const LAS bf16x8*)(AT + (rg * 16 + fr) * CST + ks * 64 + fq * 16);
#pragma unroll
                for (int nt = 0; nt < 4; ++nt) { const bf16x8 bfr = *(const LAS bf16x8*)(BT + (ch * 64 + nt * 16 + fr) * CST + ks * 64 + fq * 16);
                    acc[nt] = __builtin_amdgcn_mfma_f32_16x16x32_bf16(af, bfr, acc[nt], 0, 0, 0); }
            }
        }
#undef CMP_LOAD
#pragma unroll
        for (int nt = 0; nt < 4; ++nt) { const int col = ch * 64 + nt * 16 + fr; const float bb = b1[col];
#pragma unroll
            for (int r = 0; r < 4; ++r) { const float hv = pg8::silu_f(acc[nt][r] + bb); H[(rg * 16 + 4 * fq + r) * 136 + col] = (bf16_t)(cvtpk(hv, 0.f) & 0xffffu); } }
        __syncthreads();
        f32x4 o2[2]; o2[0] = (f32x4){0.f, 0.f, 0.f, 0.f}; o2[1] = (f32x4){0.f, 0.f, 0.f, 0.f};
#pragma unroll
        for (int ks = 0; ks < 4; ++ks) {
            const bf16x8 af = *(const LAS bf16x8*)(H + (rg * 16 + fr) * 136 + ks * 32 + 8 * fq);
#pragma unroll
            for (int nt = 0; nt < 2; ++nt) { const bf16x8 bfr = *(const bf16x8*)(w2t + (size_t)(ch * 32 + nt * 16 + fr) * 128 + ks * 32 + 8 * fq);
                o2[nt] = __builtin_amdgcn_mfma_f32_16x16x32_bf16(af, bfr, o2[nt], 0, 0, 0); }
        }
        const int c0 = half * 64 + rg * 16 + 4 * fq;
#pragma unroll
        for (int nt = 0; nt < 2; ++nt) { const int d = ch * 32 + nt * 16 + fr;
            if (kv == 0) { bf16_t* kc = (bf16_t*)(ws + WS_KCMP) + (size_t)bg * 128 * 64;
#pragma unroll
                for (int r = 0; r < 4; ++r) { const int cc = c0 + r; kc[cc * 64 + d] = (cc == 127) ? (bf16_t)0 : (bf16_t)(cvtpk(o2[nt][r], 0.f) & 0xffffu); }
            } else { bf16_t* vc = (bf16_t*)(ws + WS_VCMPT) + (size_t)bg * 64 * 128;
                u32x2 w; w.x = cvtpk(o2[nt][0], o2[nt][1]); w.y = cvtpk(o2[nt][2], (c0 + 3 == 127) ? 0.f : o2[nt][3]);
                *(u32x2*)(vc + d * 128 + ((c0 & ~15) | ((c0 & 4) << 1) | ((c0 & 8) >> 1))) = w; }
        }
        __syncthreads();
    }
}

#define MFMA32(a, b, c) __builtin_amdgcn_mfma_f32_32x32x16_bf16((a), (b), (c), 0, 0, 0)
constexpr float NEG_INF = -INFINITY;
constexpr float RESCALE_THR = 6.0f;

__device__ __forceinline__ float xhalf_max(float v) { auto rr = __builtin_amdgcn_permlane32_swap(__float_as_uint(v), __float_as_uint(v), false, false); return fmaxf(__uint_as_float(rr[0]), __uint_as_float(rr[1])); }
__device__ __forceinline__ float xhalf_sum(float v) { auto rr = __builtin_amdgcn_permlane32_swap(__float_as_uint(v), __float_as_uint(v), false, false); return __uint_as_float(rr[0]) + __uint_as_float(rr[1]); }

template <int RS>
__device__ __forceinline__ void lds_frag8(bf16x8 (&f)[8], unsigned addr) {
    asm volatile("ds_read_b128 %0, %8\n\tds_read_b128 %1, %8 offset:%c9\n\tds_read_b128 %2, %8 offset:32\n\tds_read_b128 %3, %8 offset:%c10\n\t"
                 "ds_read_b128 %4, %8 offset:64\n\tds_read_b128 %5, %8 offset:%c11\n\tds_read_b128 %6, %8 offset:96\n\tds_read_b128 %7, %8 offset:%c12"
                 : "=&v"(f[0]), "=&v"(f[1]), "=&v"(f[2]), "=&v"(f[3]), "=&v"(f[4]), "=&v"(f[5]), "=&v"(f[6]), "=&v"(f[7])
                 : "v"(addr), "i"(RS), "i"(RS + 32), "i"(RS + 64), "i"(RS + 96));
}
template <int RS>
__device__ __forceinline__ void lds_frag8v(bf16x8 (&f)[8], unsigned addr) {
    asm volatile("ds_read_b128 %0, %8\n\tds_read_b128 %1, %8 offset:%c9\n\tds_read_b128 %2, %8 offset:%c10\n\tds_read_b128 %3, %8 offset:%c11\n\t"
                 "ds_read_b128 %4, %8 offset:32\n\tds_read_b128 %5, %8 offset:%c12\n\tds_read_b128 %6, %8 offset:%c13\n\tds_read_b128 %7, %8 offset:%c14"
                 : "=&v"(f[0]), "=&v"(f[1]), "=&v"(f[2]), "=&v"(f[3]), "=&v"(f[4]), "=&v"(f[5]), "=&v"(f[6]), "=&v"(f[7])
                 : "v"(addr), "i"(RS), "i"(2 * RS), "i"(3 * RS), "i"(RS + 32), "i"(2 * RS + 32), "i"(3 * RS + 32));
}
__device__ __forceinline__ void lds_wait8(bf16x8 (&f)[8]) {
    asm volatile("s_waitcnt lgkmcnt(0)" : "+v"(f[0]), "+v"(f[1]), "+v"(f[2]), "+v"(f[3]), "+v"(f[4]), "+v"(f[5]), "+v"(f[6]), "+v"(f[7]));
}
__device__ __forceinline__ void lds_wait16(bf16x8 (&f)[8], bf16x8 (&g)[8]) {
    asm volatile("s_waitcnt lgkmcnt(0)" : "+v"(f[0]), "+v"(f[1]), "+v"(f[2]), "+v"(f[3]), "+v"(f[4]), "+v"(f[5]), "+v"(f[6]), "+v"(f[7]),
                 "+v"(g[0]), "+v"(g[1]), "+v"(g[2]), "+v"(g[3]), "+v"(g[4]), "+v"(g[5]), "+v"(g[6]), "+v"(g[7]));
}
__device__ __forceinline__ void qk_frags(f32x16& p0, f32x16& p1, const bf16x8 (&kf)[8], const bf16x8 (&qf)[4], float init) {
#pragma unroll
    for (int r = 0; r < 16; ++r) { p0[r] = init; p1[r] = init; }
#pragma unroll
    for (int ds = 0; ds < 4; ++ds) { p0 = MFMA32(kf[2 * ds], qf[ds], p0); p1 = MFMA32(kf[2 * ds + 1], qf[ds], p1); }
}
__device__ __forceinline__ bf16x8 pack8(const f32x16& P, int base) {
    u32x4 pw; pw.x = cvtpk(P[base], P[base + 1]); pw.y = cvtpk(P[base + 2], P[base + 3]); pw.z = cvtpk(P[base + 4], P[base + 5]); pw.w = cvtpk(P[base + 6], P[base + 7]);
    return __builtin_bit_cast(bf16x8, pw);
}
__device__ __forceinline__ void near_bias(f32x16& p0, f32x16& p1, int D0, const LAS float* luth) {
    const LAS float* b = luth + (D0 - 59);
#pragma unroll
    for (int sub = 0; sub < 2; ++sub) {
        float bv[16];
#pragma unroll
        for (int r = 0; r < 16; ++r) bv[r] = b[59 - 32 * sub - (r & 3) - 8 * (r >> 2)];
#pragma unroll
        for (int r = 0; r < 16; ++r) asm volatile("" : "+v"(bv[r]));
#pragma unroll
        for (int r = 0; r < 16; ++r) { if (sub) p1[r] += bv[r]; else p0[r] += bv[r]; }
    }
}
__device__ __forceinline__ void far_mask(f32x16& p0, f32x16& p1, int D0, int dlim) {
#pragma unroll
    for (int e = 0; e < 32; ++e) { const int r = e & 15, sub = e >> 4; const int dist = D0 - 32 * sub - (r & 3) - 8 * (r >> 2);
        if (sub) p1[r] = (dist >= 0 && dist < dlim) ? p1[r] : NEG_INF; else p0[r] = (dist >= 0 && dist < dlim) ? p0[r] : NEG_INF; }
}
template <int ND>
__device__ __forceinline__ void softmax_decide(f32x16& p0, f32x16& p1, float& mref, float& l, bool& seen, f32x16 (&o)[ND]) {
    float a = fmaxf(fmaxf(p0[0], p0[1]), p1[0]), b = fmaxf(fmaxf(p0[2], p0[3]), p1[1]); a = fmaxf(fmaxf(a, p1[2]), p1[3]);
#pragma unroll
    for (int r = 4; r < 16; r += 4) { a = fmaxf(fmaxf(a, p0[r]), p0[r + 1]); b = fmaxf(fmaxf(b, p0[r + 2]), p0[r + 3]); a = fmaxf(fmaxf(a, p1[r]), p1[r + 1]); b = fmaxf(fmaxf(b, p1[r + 2]), p1[r + 3]); }
    const float rm = xhalf_max(fmaxf(a, b));
    const bool fin = rm > NEG_INF;
    const bool cond = fin && (!seen || rm > RESCALE_THR);
    if (__any(cond)) {
        const float dl = cond ? rm : 0.f;
        mref += dl;
#pragma unroll
        for (int r = 0; r < 16; ++r) { p0[r] -= dl; p1[r] -= dl; }
        const float alpha = seen ? __builtin_amdgcn_exp2f(-dl) : 1.f;
        l *= alpha;
#pragma unroll
        for (int dt = 0; dt < ND; ++dt) o[dt] = o[dt] * alpha;
    }
    seen = seen || fin;
}
template <int ND>
__device__ __forceinline__ void softmax_decide2(f32x16& a0, f32x16& a1, f32x16& b0, f32x16& b1, bool two, float& mref, float& l, bool& seen, f32x16 (&o)[ND]) {
    float x = fmaxf(fmaxf(a0[0], a0[1]), a1[0]), y = fmaxf(fmaxf(a0[2], a0[3]), a1[1]); x = fmaxf(fmaxf(x, a1[2]), a1[3]);
#pragma unroll
    for (int r = 4; r < 16; r += 4) { x = fmaxf(fmaxf(x, a0[r]), a0[r + 1]); y = fmaxf(fmaxf(y, a0[r + 2]), a0[r + 3]); x = fmaxf(fmaxf(x, a1[r]), a1[r + 1]); y = fmaxf(fmaxf(y, a1[r + 2]), a1[r + 3]); }
    if (two) {
#pragma unroll
        for (int r = 0; r < 16; r += 4) { x = fmaxf(fmaxf(x, b0[r]), b0[r + 1]); y = fmaxf(fmaxf(y, b0[r + 2]), b0[r + 3]); x = fmaxf(fmaxf(x, b1[r]), b1[r + 1]); y = fmaxf(fmaxf(y, b1[r + 2]), b1[r + 3]); }
    }
    const float rm = xhalf_max(fmaxf(x, y));
    const bool fin = rm > NEG_INF;
    const bool cond = fin && (!seen || rm > RESCALE_THR);
    if (__any(cond)) {
        const float dl = cond ? rm : 0.f;
        mref += dl;
#pragma unroll
        for (int r = 0; r < 16; ++r) { a0[r] -= dl; a1[r] -= dl; }
        if (two) {
#pragma unroll
            for (int r = 0; r < 16; ++r) { b0[r] -= dl; b1[r] -= dl; }
        }
        const float alpha = seen ? __builtin_amdgcn_exp2f(-dl) : 1.f;
        l *= alpha;
#pragma unroll
        for (int dt = 0; dt < ND; ++dt) o[dt] = o[dt] * alpha;
    }
    seen = seen || fin;
}
__device__ __forceinline__ float tile_max(const f32x16& p0, const f32x16& p1) {
    float a = fmaxf(fmaxf(p0[0], p0[1]), p1[0]), b = fmaxf(fmaxf(p0[2], p0[3]), p1[1]); a = fmaxf(fmaxf(a, p1[2]), p1[3]);
#pragma unroll
    for (int r = 4; r < 16; r += 4) { a = fmaxf(fmaxf(a, p0[r]), p0[r + 1]); b = fmaxf(fmaxf(b, p0[r + 2]), p0[r + 3]); a = fmaxf(fmaxf(a, p1[r]), p1[r + 1]); b = fmaxf(fmaxf(b, p1[r + 2]), p1[r + 3]); }
    return xhalf_max(fmaxf(a, b));
}
__device__ __forceinline__ float tile_max2(const f32x16& a0, const f32x16& a1, const f32x16& b0, const f32x16& b1, bool two) {
    float x = fmaxf(fmaxf(a0[0], a0[1]), a1[0]), y = fmaxf(fmaxf(a0[2], a0[3]), a1[1]); x = fmaxf(fmaxf(x, a1[2]), a1[3]);
#pragma unroll
    for (int r = 4; r < 16; r += 4) { x = fmaxf(fmaxf(x, a0[r]), a0[r + 1]); y = fmaxf(fmaxf(y, a0[r + 2]), a0[r + 3]); x = fmaxf(fmaxf(x, a1[r]), a1[r + 1]); y = fmaxf(fmaxf(y, a1[r + 2]), a1[r + 3]); }
    if (two) {
#pragma unroll
        for (int r = 0; r < 16; r += 4) { x = fmaxf(fmaxf(x, b0[r]), b0[r + 1]); y = fmaxf(fmaxf(y, b0[r + 2]), b0[r + 3]); x = fmaxf(fmaxf(x, b1[r]), b1[r + 1]); y = fmaxf(fmaxf(y, b1[r + 2]), b1[r + 3]); }
    }
    return xhalf_max(fmaxf(x, y));
}
template <int ND>
__device__ __forceinline__ float ref_move(float ssum, float& mref, float& l, f32x16 (&o)[ND]) {
    const bool cond = ssum > 1024.0f;
    float dl = 0.f;
    if (__any(cond)) {
        dl = cond ? __builtin_amdgcn_logf(ssum) : 0.f;
        mref += dl;
        const float alpha = __builtin_amdgcn_exp2f(-dl);
        l *= alpha;
#pragma unroll
        for (int dt = 0; dt < ND; ++dt) o[dt] = o[dt] * alpha;
    }
    return dl;
}
__device__ __forceinline__ void softmax_exp1(f32x16& p, float& l) {
    float s0 = 0.f;
#pragma unroll
    for (int r = 0; r < 16; ++r) { p[r] = __builtin_amdgcn_exp2f(p[r]); s0 += p[r]; }
    l += s0;
}
__device__ __forceinline__ void softmax_exp(f32x16& p0, f32x16& p1, float& l) {
    float s0 = 0.f, s1 = 0.f;
#pragma unroll
    for (int r = 0; r < 16; ++r) { p0[r] = __builtin_amdgcn_exp2f(p0[r]); s0 += p0[r]; }
#pragma unroll
    for (int r = 0; r < 16; ++r) { p1[r] = __builtin_amdgcn_exp2f(p1[r]); s1 += p1[r]; }
    l += s0 + s1;
}

constexpr int NL_LUT = 0, NL_KCT = 16 * LUTN * 4, NL_VCT = NL_KCT + 128 * 144, NL_KT = NL_KCT, NL_VT = NL_KT + 4 * 9216,
              NL_IMP = NL_VT + 4 * 9216, NL_MASK = NL_IMP + 4 * 64 * 33 * 4, NL_UNI = NL_MASK + 256, NL_END = NL_MASK + 512;
static_assert(NL_VCT + 64 * 272 <= NL_IMP, "nsa lds overlay");
static_assert(NL_END <= 131072, "nsa lds");
__device__ __forceinline__ void nsa_phase(const Ctx& C, const Args& a) {
    unsigned char* ws = a.ws;
    LAS unsigned char* lds = C.lds;
    LAS float* LUT = (LAS float*)(lds + NL_LUT);
    LAS float* IMP = (LAS float*)(lds + NL_IMP);
    LAS unsigned* MASK = (LAS unsigned*)(lds + NL_MASK);
    LAS unsigned* UNI = (LAS unsigned*)(lds + NL_UNI);
    { u32x4 lv[3];
#pragma unroll
      for (int i = 0; i < 3; ++i) { const int idx = C.tid + NTHREADS * i; lv[i] = (idx < 16 * LUTN / 4) ? ((const u32x4*)(ws + WS_LUT))[idx] : (u32x4){}; }
#pragma unroll
      for (int i = 0; i < 3; ++i) { const int idx = C.tid + NTHREADS * i; if (idx < 16 * LUTN / 4) ((LAS u32x4*)LUT)[idx] = lv[i]; } }
    const bf16_t* Q0 = (const bf16_t*)(ws + WS_R1);
    const bf16_t* SZ = (const bf16_t*)(ws + WS_R4);
    bf16_t* O0 = (bf16_t*)(ws + WS_R0);
    const float* GATE = (const float*)(ws + WS_GATE);
    for (int it = 0;; ++it) {
        int bg, qb;
        if (C.G == 256) { if (it >= 8) break; const int x = C.vcu >> 5, c = C.vcu & 31, rr = it >> 1, p = ((c & 15) + 4 * rr) & 15, q = (c >> 4) ? 31 - p : p;
            bg = x * 8 + rr * 2 + (it & 1); qb = (it & 1) ? 31 - q : q; }
        else { const int u = C.vcu + it * C.G; if (u >= 2048) break; bg = u >> 5; qb = u & 31; }
        int tid = C.tid; asm volatile("" : "+v"(tid));
        const int lane = tid & 63, wid = __builtin_amdgcn_readfirstlane(tid >> 6), r32 = lane & 31, hi = lane >> 5, j = wid >> 1, th = wid & 1;
        const int b = bg >> 2, g = bg & 3, head = g * 4 + j, start = qb * 64, cur = qb;
        const size_t rowb = (size_t)b * SEQ;
        const int t = start + 32 * th + r32;
        {
            const bf16_t* kc = (const bf16_t*)(ws + WS_KCMP) + (size_t)bg * 128 * 64;
            const bf16_t* vc = (const bf16_t*)(ws + WS_VCMPT) + (size_t)bg * 64 * 128;
#pragma unroll
            for (int i = 0; i < 2; ++i) { const int idx = tid + NTHREADS * i;
                { const int row = idx >> 3, chn = idx & 7; const u32x4 v = *(const u32x4*)(kc + row * 64 + chn * 8); *(LAS u32x4*)(lds + NL_KCT + row * 144 + chn * 16) = v; }
                { const int row = idx >> 4, chn = idx & 15; const u32x4 v = *(const u32x4*)(vc + row * 128 + chn * 8); *(LAS u32x4*)(lds + NL_VCT + row * 272 + chn * 16) = v; } }
        }
        bf16x8 qf[4];
        { const bf16_t* qp = Q0 + (rowb + t) * DM + head * 64 + 8 * hi;
#pragma unroll
          for (int ds = 0; ds < 4; ++ds) qf[ds] = *(const bf16x8*)(qp + 16 * ds); }
        const float* gp = GATE + (rowb + t) * 48 + head * 3; const float g0 = gp[0], g1 = gp[1], g2 = gp[2];
        const LAS float* luth = LUT + head * LUTN + LPAD;
        __syncthreads();
        unsigned accp[16];
        {
            f32x16 s[4];
            {
                const unsigned ka = (unsigned)(uintptr_t)(lds + NL_KCT + r32 * 144 + 16 * hi);
                bf16x8 kfa[8], kfb[8];
                lds_frag8<32 * 144>(kfa, ka); lds_wait8(kfa);
                qk_frags(s[0], s[1], kfa, qf, 0.f);
                if (cur >= 16) { lds_frag8<32 * 144>(kfb, ka + 64 * 144); lds_wait8(kfb); qk_frags(s[2], s[3], kfb, qf, 0.f); }
                else {
#pragma unroll
                    for (int r = 0; r < 16; ++r) { s[2][r] = NEG_INF; s[3][r] = NEG_INF; } }
            }
            float mx = NEG_INF; const int Dc = t - 31 - 64 * hi;
#pragma unroll
            for (int sub = 0; sub < 4; ++sub) {
                if (cur < 8 * sub) {
#pragma unroll
                    for (int r = 0; r < 16; ++r) s[sub][r] = NEG_INF;
                    continue; }
                if (cur >= 8 * sub + 10) {
#pragma unroll
                    for (int r = 0; r < 16; ++r) mx = fmaxf(mx, s[sub][r]);
                    continue; }
                float bv[16];
#pragma unroll
                for (int r = 0; r < 16; ++r) { const int dist = Dc - 512 * sub - 16 * (r & 3) - 128 * (r >> 2); int di = dist < 0 ? 0 : dist; di = di > 127 ? 127 : di; bv[r] = luth[di]; }
#pragma unroll
                for (int r = 0; r < 16; ++r) asm volatile("" : "+v"(bv[r]));
#pragma unroll
                for (int r = 0; r < 16; ++r) { const int dist = Dc - 512 * sub - 16 * (r & 3) - 128 * (r >> 2);
                    const float v = (dist >= 0) ? s[sub][r] + bv[r] : NEG_INF; s[sub][r] = v; mx = fmaxf(mx, v); }
            }
            mx = xhalf_max(mx);
            const float mu = (mx == NEG_INF) ? 0.f : mx; float sum = 0.f;
#pragma unroll
            for (int sub = 0; sub < 4; ++sub) {
                if (cur < 8 * sub) {
#pragma unroll
                    for (int r = 0; r < 16; ++r) s[sub][r] = 0.f;
                    continue; }
#pragma unroll
                for (int r = 0; r < 16; ++r) { s[sub][r] = __builtin_amdgcn_exp2f(s[sub][r] - mu); sum += s[sub][r]; }
            }
            sum = xhalf_sum(sum);
            const float inv = sum > 0.f ? 1.0f / sum : 0.f;
            if (cur >= 8) {
            float recv[4][4];
#pragma unroll
            for (int sub = 0; sub < 4; ++sub)
#pragma unroll
                for (int aa = 0; aa < 4; ++aa) { const float tv = 0.5f * inv * s[sub][4 * aa + 3]; auto rr = __builtin_amdgcn_permlane32_swap(__float_as_uint(tv), __float_as_uint(tv), false, false); recv[sub][aa] = __uint_as_float(hi ? rr[0] : rr[1]); }
            LAS float* imp = IMP + (j * 64 + 32 * th + r32) * 33;
#pragma unroll
            for (int sub = 0; sub < 4; ++sub)
#pragma unroll
                for (int aa = 0; aa < 4; ++aa) {
                    const float mainv = s[sub][4 * aa] + s[sub][4 * aa + 1] + s[sub][4 * aa + 2] + 0.5f * s[sub][4 * aa + 3];
                    const float prev = (aa > 0) ? recv[sub][aa > 0 ? aa - 1 : 0] : ((sub > 0) ? recv[sub > 0 ? sub - 1 : 0][3] : 0.f);
                    imp[8 * sub + 2 * aa + hi] = mainv * inv + (hi ? recv[sub][aa] : prev);
                }
            }
            f32x16 o[2]; o[0] = (f32x16){}; o[1] = (f32x16){};
            const unsigned va = (unsigned)(uintptr_t)(lds + NL_VCT + r32 * 272 + 16 * hi);
#pragma unroll
            for (int hb = 0; hb < 2; ++hb) {
                if (hb == 1 && cur < 16) continue;
                bf16x8 vf[8];
                lds_frag8<32 * 272>(vf, va + 128 * hb); lds_wait8(vf);
#pragma unroll
                for (int ks = 0; ks < 4; ++ks) { const bf16x8 pb = pack8(s[2 * hb + (ks >> 1)], 8 * (ks & 1)); o[0] = MFMA32(vf[2 * ks], pb, o[0]); o[1] = MFMA32(vf[2 * ks + 1], pb, o[1]); }
            }
#pragma unroll
            for (int dt = 0; dt < 2; ++dt)
#pragma unroll
                for (int r = 0; r < 16; r += 2) accp[dt * 8 + (r >> 1)] = cvtpk(o[dt][r] * (g0 * inv), o[dt][r + 1] * (g0 * inv));
        }
        __syncthreads();
        if (cur < 8) {
            if (tid < 64) MASK[tid] = 0xffffffffu >> (31 - cur);
            if (tid >= 64 && tid < 72) UNI[tid - 64] = 0xffffffffu >> (31 - cur);
            __syncthreads();
        } else {
            const int tok = tid >> 3, part = tid & 7;
            const LAS float* v0 = IMP + tok * 33;
            float v[4]; unsigned bits = 0u;
#pragma unroll
            for (int i = 0; i < 4; ++i) { const int n = part * 4 + i;
                const float val = ((v0[n] + v0[64 * 33 + n]) + v0[2 * 64 * 33 + n]) + v0[3 * 64 * 33 + n];
                const bool forced = (n == 0) || (n == cur) || (n == cur - 1), future = n > cur;
                if (forced) bits |= 1u << n;
                v[i] = (forced || future) ? -1.0f : val; }
#pragma unroll 1
            for (int round = 0; round < 5; ++round) {
                float bv = v[0]; int bi = part * 4;
#pragma unroll
                for (int i = 1; i < 4; ++i) { if (v[i] > bv) { bv = v[i]; bi = part * 4 + i; } }
#pragma unroll
                for (int st = 0; st < 3; ++st) { const float ov = st == 0 ? dpp_f<DPP_XOR1>(bv) : st == 1 ? dpp_f<DPP_XOR2>(bv) : dpp_f<DPP_HALF_MIRROR>(bv);
                    const int oi = st == 0 ? dpp_i<DPP_XOR1>(bi) : st == 1 ? dpp_i<DPP_XOR2>(bi) : dpp_i<DPP_HALF_MIRROR>(bi);
                    const bool take = (ov > bv) || (ov == bv && oi < bi); bv = take ? ov : bv; bi = take ? oi : bi; }
                if (bv >= 0.f && (bi >> 2) == part) { bits |= 1u << bi;
#pragma unroll
                    for (int i = 0; i < 4; ++i) if (part * 4 + i == bi) v[i] = -1.0f; }
            }
            unsigned tm = bits;
            tm |= (unsigned)dpp_i<DPP_XOR1>((int)tm); tm |= (unsigned)dpp_i<DPP_XOR2>((int)tm); tm |= (unsigned)dpp_i<DPP_HALF_MIRROR>((int)tm);
            if (part == 0) MASK[tok] = tm;
            unsigned wm = tm | (unsigned)dpp_i<DPP_ROW_MIRROR>((int)tm);
            { auto rr = __builtin_amdgcn_permlane16_swap(wm, wm, false, false); wm = rr[0] | rr[1]; }
            { auto rr = __builtin_amdgcn_permlane32_swap(wm, wm, false, false); wm = rr[0] | rr[1]; }
            if ((tid & 63) == 0) UNI[tid >> 6] = wm;
            __syncthreads();
        }
        LAS unsigned* ACCL = (LAS unsigned*)(lds + NL_IMP) + wid * 1024 + lane;
#pragma unroll
        for (int q = 0; q < 16; ++q) ACCL[q * 64] = accp[q];
        const unsigned mymask = MASK[32 * th + r32];
        const unsigned le_cur = 0xffffffffu >> (31 - cur);
        const u32x4 un0 = *(const LAS u32x4*)UNI, un1 = *(const LAS u32x4*)(UNI + 4);
        const unsigned selt = ((un0.x | un0.y) | (un0.z | un0.w) | (un1.x | un1.y) | (un1.z | un1.w)) & le_cur;
        const int wlo = cur > 8 ? cur - 8 : 0;
        const unsigned wint = le_cur & ~((1u << wlo) - 1u);
        const float cb = luth[127];
        i32x8 qf8;
#pragma unroll
        for (int ds = 0; ds < 4; ++ds) { const u32x4 qw = __builtin_bit_cast(u32x4, qf[ds]);
            qf8[2 * ds] = (int)pg8::cvt4_fp8(bf2f(qw.x & 0xffffu) * 16.0f, bf2f(qw.x >> 16) * 16.0f, bf2f(qw.y & 0xffffu) * 16.0f, bf2f(qw.y >> 16) * 16.0f);
            qf8[2 * ds + 1] = (int)pg8::cvt4_fp8(bf2f(qw.z & 0xffffu) * 16.0f, bf2f(qw.z >> 16) * 16.0f, bf2f(qw.w & 0xffffu) * 16.0f, bf2f(qw.w >> 16) * 16.0f); }
#define NSA_QK(p0_, p1_, ka_, init_) do { const LAS unsigned char* ka__ = (ka_); \
            const i32x4 ka0 = *(const LAS i32x4*)ka__, ka1 = *(const LAS i32x4*)(ka__ + 16), kb0 = *(const LAS i32x4*)(ka__ + 32 * 80), kb1 = *(const LAS i32x4*)(ka__ + 32 * 80 + 16); \
            const i32x8 kA_ = __builtin_shufflevector(ka0, ka1, 0, 1, 2, 3, 4, 5, 6, 7), kB_ = __builtin_shufflevector(kb0, kb1, 0, 1, 2, 3, 4, 5, 6, 7); \
            f32x16 ci_; const float iv_ = (init_); _Pragma("unroll") for (int r = 0; r < 16; ++r) ci_[r] = iv_; \
            p0_ = __builtin_amdgcn_mfma_scale_f32_32x32x64_f8f6f4(kA_, qf8, ci_, 0, 0, 0, 0x7d7d7d7d, 0, 0x7b7b7b7b); \
            p1_ = __builtin_amdgcn_mfma_scale_f32_32x32x64_f8f6f4(kB_, qf8, ci_, 0, 0, 0, 0x7d7d7d7d, 0, 0x7b7b7b7b); } while (0)
#pragma unroll 1
        for (int br = 0; br < 2; ++br) {
            const unsigned char* Kg = ws + (br ? WS_R3 : WS_R2 + 32 * MiB) + rowb * 256 + g * 64;
            const bf16_t* Vg = (const bf16_t*)(ws + (br ? WS_R3 + 16 * MiB : WS_R2 + 48 * MiB)) + ((size_t)b * 256 + g * 64) * SEQ;
            float mref = 0.f, l = 0.f; bool seen = false; f32x16 o[2]; o[0] = (f32x16){}; o[1] = (f32x16){};
            const int srow = tid >> 3, sch = tid & 7;
            const LAS unsigned char* kra = lds + NL_KT + r32 * 80 + 32 * hi;
            const unsigned vra = (unsigned)(uintptr_t)(lds + NL_VT + r32 * 144 + 16 * hi);
            LAS unsigned char* kst = lds + NL_KT + srow * 80 + sch * 8;
            LAS unsigned char* vst = lds + NL_VT + srow * 144 + sch * 16;
            const unsigned kgo_ = (unsigned)srow * 256 + sch * 8;
#define kgp (Kg + (size_t)kgo_)
            const unsigned vgo_ = (unsigned)srow * SEQ + sch * 8;
#define vgp (Vg + (size_t)vgo_)
            unsigned rem = br ? wint : selt;
            int ta = __builtin_ctz(rem); rem &= rem - 1u;
            int tb = rem ? __builtin_ctz(rem) : -1; if (tb >= 0) rem &= rem - 1u;
            u32x4 vA, vB; u32x2 kA, kB;
            {
                const int tbb = tb >= 0 ? tb : ta;
                kA = *(const u32x2*)(kgp + (size_t)ta * (64 * 256)); vA = *(const u32x4*)(vgp + ta * 64);
                kB = *(const u32x2*)(kgp + (size_t)tbb * (64 * 256)); vB = *(const u32x4*)(vgp + tbb * 64);
                *(LAS u32x2*)kst = kA; *(LAS u32x2*)(kst + 9216) = kB; *(LAS u32x4*)vst = vA; *(LAS u32x4*)(vst + 9216) = vB;
            }
            __syncthreads();
#define NSA_LANEOK(tt) (br ? true : (((mymask >> (tt)) & 1u) != 0u))
#define NSA_INIT(tt) ((NSA_LANEOK(tt) ? 0.f : NEG_INF) - mref)
            int sidx = 0;
#pragma unroll 1
            for (;;) {
                int tc = -1, td = -1;
                if (rem) { tc = __builtin_ctz(rem); rem &= rem - 1u; if (rem) { td = __builtin_ctz(rem); rem &= rem - 1u; } }
                if (tc >= 0) { const int tdd = td >= 0 ? td : tc;
                    kA = *(const u32x2*)(kgp + (size_t)tc * (64 * 256)); vA = *(const u32x4*)(vgp + tc * 64);
                    kB = *(const u32x2*)(kgp + (size_t)tdd * (64 * 256)); vB = *(const u32x4*)(vgp + tdd * 64); }
                const int po = (sidx & 1) * (2 * 9216), pn = (2 * 9216) - po;
                const bool two = tb >= 0;
                f32x16 a0, a1, b0, b1;
                NSA_QK(a0, a1, kra + po, NSA_INIT(ta));
                if (two) NSA_QK(b0, b1, kra + po + 9216, NSA_INIT(tb));
                {
                    const int D0 = t - 64 * ta - 4 * hi;
                    if (ta >= cur - 2) near_bias(a0, a1, D0, luth);
                    else if (br && ta == cur - 8) far_mask(a0, a1, D0, 512);
                }
                if (two) {
                    const int D0 = t - 64 * tb - 4 * hi;
                    if (tb >= cur - 2) near_bias(b0, b1, D0, luth);
                    else if (br && tb == cur - 8) far_mask(b0, b1, D0, 512);
                }
                if (sidx == 0) softmax_decide2<2>(a0, a1, b0, b1, two, mref, l, seen, o);
                float lstep = 0.f;
                bf16x8 vfa[8], vfb[8];
                lds_frag8<32 * 144>(vfa, vra + po);
                softmax_exp(a0, a1, lstep);
                if (two) softmax_exp(b0, b1, lstep);
                l += lstep;
                lds_wait8(vfa);
#pragma unroll
                for (int ks = 0; ks < 4; ++ks) { const bf16x8 pb = pack8(ks < 2 ? a0 : a1, 8 * (ks & 1)); o[0] = MFMA32(vfa[2 * ks], pb, o[0]); o[1] = MFMA32(vfa[2 * ks + 1], pb, o[1]); }
                lds_frag8<32 * 144>(vfb, vra + po + 9216);
                lds_wait8(vfb);
                if (two) {
#pragma unroll
                    for (int ks = 0; ks < 4; ++ks) { const bf16x8 pb = pack8(ks < 2 ? b0 : b1, 8 * (ks & 1)); o[0] = MFMA32(vfb[2 * ks], pb, o[0]); o[1] = MFMA32(vfb[2 * ks + 1], pb, o[1]); }
                }
                if (tc >= 0) { *(LAS u32x2*)(kst + pn) = kA; *(LAS u32x2*)(kst + pn + 9216) = kB; *(LAS u32x4*)(vst + pn) = vA; *(LAS u32x4*)(vst + pn + 9216) = vB; }
                if (sidx != 0) (void)ref_move<2>(xhalf_sum(lstep), mref, l, o);
                __syncthreads();
                if (tc < 0) break;
                ta = tc; tb = td; ++sidx;
            }
#undef NSA_LANEOK
#undef NSA_QK
#undef NSA_INIT
#undef kgp
#undef vgp
            l = xhalf_sum(l);
            const float sc = (br ? g2 : g1) / l;
            if (br == 0) {
#pragma unroll
                for (int dt = 0; dt < 2; ++dt)
#pragma unroll
                    for (int r = 0; r < 16; r += 2) { const unsigned w = ACCL[(dt * 8 + (r >> 1)) * 64]; ACCL[(dt * 8 + (r >> 1)) * 64] = cvtpk(bf2f(w & 0xffffu) + o[dt][r] * sc, bf2f(w >> 16) + o[dt][r + 1] * sc); }
            } else {
                LAS unsigned char* stg = lds + NL_VT + wid * (32 * 144);
                u32x4 zz[4];
#pragma unroll
                for (int i = 0; i < 4; ++i) zz[i] = *(const u32x4*)(SZ + (rowb + start + 32 * th + i * 8 + (lane >> 3)) * DM + head * 64 + (lane & 7) * 8);
#pragma unroll
                for (int dt = 0; dt < 2; ++dt)
#pragma unroll
                    for (int aa = 0; aa < 4; ++aa) {
                        const unsigned wa = ACCL[(dt * 8 + 2 * aa) * 64], wb = ACCL[(dt * 8 + 2 * aa + 1) * 64];
                        const float f0 = bf2f(wa & 0xffffu) + o[dt][4 * aa] * sc, f1 = bf2f(wa >> 16) + o[dt][4 * aa + 1] * sc, f2 = bf2f(wb & 0xffffu) + o[dt][4 * aa + 2] * sc, f3 = bf2f(wb >> 16) + o[dt][4 * aa + 3] * sc;
                        *(LAS u32x2*)(stg + r32 * 144 + (32 * dt + 8 * aa + 4 * hi) * 2) = (u32x2){cvtpk(f0, f1), cvtpk(f2, f3)}; }
                LDS_WAIT(); asm volatile("" ::: "memory");
#pragma unroll
                for (int i = 0; i < 4; ++i) { const int row = i * 8 + (lane >> 3), chn = lane & 7;
                    const size_t off = (rowb + start + 32 * th + row) * DM + head * 64 + chn * 8;
                    const u32x4 v = *(const LAS u32x4*)(stg + row * 144 + chn * 16), z = zz[i];
                    u32x4 w;
                    w.x = cvtpk(bf2f(v.x & 0xffffu) * bf2f(z.x & 0xffffu), bf2f(v.x >> 16) * bf2f(z.x >> 16)); w.y = cvtpk(bf2f(v.y & 0xffffu) * bf2f(z.y & 0xffffu), bf2f(v.y >> 16) * bf2f(z.y >> 16));
                    w.z = cvtpk(bf2f(v.z & 0xffffu) * bf2f(z.z & 0xffffu), bf2f(v.z >> 16) * bf2f(z.z >> 16)); w.w = cvtpk(bf2f(v.w & 0xffffu) * bf2f(z.w & 0xffffu), bf2f(v.w >> 16) * bf2f(z.w >> 16));
                    pg8::st16_wt(O0 + off, w); }
            }
        }
    }
}

constexpr int DL_LUT = 0, DL_KT = 16 * LUTN * 4, DL_VT = DL_KT + 2 * 64 * 272, DL_SUB = DL_VT + 2 * 128 * 144, DL_END = DL_SUB + 1024 * 4, DL_X = DL_KT;
static_assert(DL_END <= 131072 && DL_END - DL_X >= 65536, "diff lds");
__device__ __forceinline__ void diff_phase(const Ctx& C, const Args& a) {
    unsigned char* ws = a.ws;
    LAS unsigned char* lds = C.lds;
    LAS float* LUT = (LAS float*)(lds + DL_LUT);
    { u32x4 lv[3];
#pragma unroll
      for (int i = 0; i < 3; ++i) { const int idx = C.tid + NTHREADS * i; lv[i] = (idx < 16 * LUTN / 4) ? ((const u32x4*)(ws + WS_LUT))[idx] : (u32x4){}; }
#pragma unroll
      for (int i = 0; i < 3; ++i) { const int idx = C.tid + NTHREADS * i; if (idx < 16 * LUTN / 4) ((LAS u32x4*)LUT)[idx] = lv[i]; } }
    const unsigned char* Q1 = ws + WS_R1;
    const unsigned char* K1 = ws + WS_R2;
    const bf16_t* V1T = (const bf16_t*)(ws + WS_R3);
    const bf16_t* SZ = (const bf16_t*)(ws + WS_R4);
    unsigned char* O1 = ws + WS_R0;
    const float lam = *(const float*)(ws + WS_LAM);
    const float* subln = a.in[17];
    if (C.tid < 256) ((LAS f32x4*)(lds + DL_SUB))[C.tid] = ((const f32x4*)subln)[C.tid];
    __syncthreads();
    for (int it = 0;; ++it) {
        int bh, qblk;
        if (C.G == 256) { if (it >= 8) break; const int x = C.vcu >> 5, c = C.vcu & 31, cc = c & 15; bh = x * 16 + (it >> 1) * 4 + 2 * (c >> 4) + (it & 1); qblk = (it & 1) ? 15 - cc : cc; }
        else { const int u = C.vcu + it * C.G; if (u >= 2048) break; bh = u >> 4; qblk = u & 15; }
        int tid = C.tid; asm volatile("" : "+v"(tid));
        const int lane = tid & 63, wid = __builtin_amdgcn_readfirstlane(tid >> 6), r32 = lane & 31, hi = lane >> 5, mp = wid >> 2, sb = wid & 3;
        const int b = bh >> 3, h = bh & 7, start = qblk * 128;
        const size_t rowb = (size_t)b * SEQ;
        const int qlo = start + 32 * sb, t = qlo + r32;
        const LAS float* luth = LUT + (2 * h + mp) * LUTN + LPAD;
        const float cb = luth[127];
        i32x8 qf8;
        { const unsigned char* qp = Q1 + (rowb + t) * DM + h * 128 + mp * 64 + 32 * hi;
          const i32x4 q0 = *(const i32x4*)qp, q1 = *(const i32x4*)(qp + 16); qf8 = __builtin_shufflevector(q0, q1, 0, 1, 2, 3, 4, 5, 6, 7); }
        const unsigned char* Kg = K1 + rowb * DM + h * 128;
        const bf16_t* Vg = V1T + ((size_t)b * DM + h * 128) * SEQ;
        const int NT = 2 * qblk + 2;
        float mref = 0.f, l = 0.f; bool seen = false; f32x16 o[4];
#pragma unroll
        for (int dt = 0; dt < 4; ++dt) o[dt] = (f32x16){};
        const unsigned kgo = (unsigned)(tid >> 3) * DM + (tid & 7) * 16;
#define kgp (Kg + (size_t)kgo)
        const unsigned vgo = (unsigned)(tid >> 3) * SEQ + (tid & 7) * 8;
#define vgp (Vg + (size_t)vgo)
        LAS unsigned char* kst = lds + DL_KT + (tid >> 3) * 144 + (tid & 7) * 16;
        LAS unsigned char* vst = lds + DL_VT + (tid >> 3) * 144 + (tid & 7) * 16;
        const LAS unsigned char* kra = lds + DL_KT + r32 * 144 + mp * 64 + 32 * hi;
        const unsigned vra = (unsigned)(uintptr_t)(lds + DL_VT + r32 * 144 + 16 * hi);
        u32x4 kA_, vA_[2], kB_, vB_[2];
        {
            const u32x4 k0r = *(const u32x4*)kgp, k1r = *(const u32x4*)(kgp + (size_t)64 * DM);
            u32x4 v0r[2];
#pragma unroll
            for (int i = 0; i < 2; ++i) v0r[i] = *(const u32x4*)(vgp + (size_t)(64 * i) * SEQ);
            if (NT > 2) kA_ = *(const u32x4*)(kgp + (size_t)(64 * 2) * DM);
#pragma unroll
            for (int i = 0; i < 2; ++i) vA_[i] = *(const u32x4*)(vgp + (size_t)(64 * i) * SEQ + 64);
            *(LAS u32x4*)kst = k0r; *(LAS u32x4*)(kst + 64 * 272) = k1r;
#pragma unroll
            for (int i = 0; i < 2; ++i) *(LAS u32x4*)(vst + i * 64 * 144) = v0r[i];
        }
        __syncthreads();
#define DF_ACTIVE(n) (64 * (n) <= qlo + 31)
#define DF_NEAR(n) ((qlo - (64 * (n) + 63)) < 113)
#define DF_INIT(n) (-mref)
#define DF_QK(p0_, p1_, ka_, init_) do { const LAS unsigned char* ka__ = (ka_); \
            const i32x4 ka0 = *(const LAS i32x4*)ka__, ka1 = *(const LAS i32x4*)(ka__ + 16), kb0 = *(const LAS i32x4*)(ka__ + 32 * 144), kb1 = *(const LAS i32x4*)(ka__ + 32 * 144 + 16); \
            const i32x8 kA = __builtin_shufflevector(ka0, ka1, 0, 1, 2, 3, 4, 5, 6, 7), kB = __builtin_shufflevector(kb0, kb1, 0, 1, 2, 3, 4, 5, 6, 7); \
            f32x16 ci_; const float iv_ = (init_); _Pragma("unroll") for (int r = 0; r < 16; ++r) ci_[r] = iv_; \
            p0_ = __builtin_amdgcn_mfma_scale_f32_32x32x64_f8f6f4(kA, qf8, ci_, 0, 0, 0, 0x7d7d7d7d, 0, 0x7b7b7b7b); \
            p1_ = __builtin_amdgcn_mfma_scale_f32_32x32x64_f8f6f4(kB, qf8, ci_, 0, 0, 0, 0x7d7d7d7d, 0, 0x7b7b7b7b); } while (0)
#define DF_QKV(p0_, p1_, ka_, civ_) do { const LAS unsigned char* ka__ = (ka_); \
            const i32x4 ka0 = *(const LAS i32x4*)ka__, ka1 = *(const LAS i32x4*)(ka__ + 16), kb0 = *(const LAS i32x4*)(ka__ + 32 * 144), kb1 = *(const LAS i32x4*)(ka__ + 32 * 144 + 16); \
            const i32x8 kA = __builtin_shufflevector(ka0, ka1, 0, 1, 2, 3, 4, 5, 6, 7), kB = __builtin_shufflevector(kb0, kb1, 0, 1, 2, 3, 4, 5, 6, 7); \
            p0_ = __builtin_amdgcn_mfma_scale_f32_32x32x64_f8f6f4(kA, qf8, civ_, 0, 0, 0, 0x7d7d7d7d, 0, 0x7b7b7b7b); \
            p1_ = __builtin_amdgcn_mfma_scale_f32_32x32x64_f8f6f4(kB, qf8, civ_, 0, 0, 0, 0x7d7d7d7d, 0, 0x7b7b7b7b); } while (0)
        f32x16 c0, c1;
        DF_QK(c0, c1, kra, DF_INIT(0));
        __syncthreads();
        auto step = [&](const int n, const int cb_, u32x4& kcur, u32x4 (&vcur)[2], u32x4& knxt, u32x4 (&vnxt)[2]) __attribute__((always_inline)) {
            const bool has1 = (n + 1 < NT), has2 = (n + 2 < NT), has3 = (n + 3 < NT);
            if (has3) knxt = *(const u32x4*)(kgp + (size_t)(64 * (n + 3)) * DM);
            if (has2) {
#pragma unroll
                for (int i = 0; i < 2; ++i) vnxt[i] = *(const u32x4*)(vgp + (size_t)(64 * i) * SEQ + 64 * (n + 2));
            }
            const int nb_ = cb_ ^ 1;
            const bool act1 = has1 && DF_ACTIVE(n + 1);
            if (DF_ACTIVE(n)) {
                const int D0 = t - 64 * n - 4 * hi;
                if (DF_NEAR(n)) near_bias(c0, c1, D0, luth);
                if (cb_ == 0 && n == 0) softmax_decide<4>(c0, c1, mref, l, seen, o);
                float lstep = 0.f;
                bf16x8 va[8];
                lds_frag8v<32 * 144>(va, vra + cb_ * (128 * 144));
                softmax_exp1(c0, lstep);
                lds_wait8(va);
#pragma unroll
                for (int ks = 0; ks < 2; ++ks) { const bf16x8 pb = pack8(c0, 8 * ks);
#pragma unroll
                    for (int dt = 0; dt < 4; ++dt) o[dt] = MFMA32(va[4 * ks + dt], pb, o[dt]); }
                bf16x8 vb[8];
                lds_frag8v<32 * 144>(vb, vra + cb_ * (128 * 144) + 64);
                softmax_exp1(c1, lstep);
                l += lstep;
                lds_wait8(vb);
#pragma unroll
                for (int ks = 0; ks < 2; ++ks) { const bf16x8 pb = pack8(c1, 8 * ks);
#pragma unroll
                    for (int dt = 0; dt < 4; ++dt) o[dt] = MFMA32(vb[4 * ks + dt], pb, o[dt]); }
                if (!(cb_ == 0 && n == 0)) (void)ref_move<4>(xhalf_sum(lstep), mref, l, o);
            }
            if (act1) DF_QK(c0, c1, kra + nb_ * (64 * 272), DF_INIT(n + 1));
            if (has2) *(LAS u32x4*)(kst + cb_ * (64 * 272)) = kcur;
            if (has1) {
#pragma unroll
                for (int i = 0; i < 2; ++i) *(LAS u32x4*)(vst + nb_ * (128 * 144) + i * 64 * 144) = vcur[i];
            }
            __syncthreads();
        };
#pragma unroll 1
        for (int n = 0; n < NT; n += 2) {
            step(n, 0, kA_, vA_, kB_, vB_);
            step(n + 1, 1, kB_, vB_, kA_, vA_);
        }
#undef DF_ACTIVE
#undef DF_NEAR
#undef DF_INIT
#undef kgp
#undef vgp
        l = xhalf_sum(l);
        const float inv = 1.0f / l;
        LAS float* X = (LAS float*)(lds + DL_X);
        if (mp == 1) {
#pragma unroll
            for (int dt = 0; dt < 4; ++dt)
#pragma unroll
                for (int r = 0; r < 16; ++r) X[((sb * 4 + dt) * 16 + r) * 64 + lane] = o[dt][r] * inv;
        }
        __syncthreads();
        if (mp == 0) {
            u32x4 zz[8];
#pragma unroll
            for (int i = 0; i < 8; ++i) zz[i] = *(const u32x4*)(SZ + (rowb + qlo + 4 * i + (lane >> 4)) * DM + h * 128 + (lane & 15) * 8);
            float ss = 0.f;
#pragma unroll
            for (int dt = 0; dt < 4; ++dt)
#pragma unroll
                for (int r = 0; r < 16; ++r) { const float av = o[dt][r] * inv - lam * X[((sb * 4 + dt) * 16 + r) * 64 + lane]; o[dt][r] = av; ss += av * av; }
            ss = xhalf_sum(ss);
            const float rs = rsqrtf(ss * (1.0f / 128.0f) + EPS) * (1.0f - LAMBDA_INIT);
            LAS unsigned char* stg = lds + DL_X + sb * 16384;
#pragma unroll
            for (int dt = 0; dt < 4; ++dt)
#pragma unroll
                for (int aa = 0; aa < 4; ++aa) { const int e = 32 * dt + 8 * aa;
                    const f32x4 sg = *(const LAS f32x4*)(lds + DL_SUB + (h * 128 + 4 * hi + e) * 4);
                    u32x2 w; w.x = cvtpk(o[dt][4 * aa] * rs * sg.x, o[dt][4 * aa + 1] * rs * sg.y); w.y = cvtpk(o[dt][4 * aa + 2] * rs * sg.z, o[dt][4 * aa + 3] * rs * sg.w);
                    *(LAS u32x2*)(stg + r32 * 272 + (4 * hi + e) * 2) = w; }
            LDS_WAIT(); asm volatile("" ::: "memory");
#pragma unroll
            for (int i = 0; i < 8; ++i) { const int row = 4 * i + (lane >> 4), chn = lane & 15;
                const u32x4 v = *(const LAS u32x4*)(stg + row * 272 + chn * 16), z = zz[i];
                u32x2 w;
                w.x = pg8::cvt4_fp8(bf2f(v.x & 0xffffu) * bf2f(z.x & 0xffffu) * F8_ASCALE, bf2f(v.x >> 16) * bf2f(z.x >> 16) * F8_ASCALE, bf2f(v.y & 0xffffu) * bf2f(z.y & 0xffffu) * F8_ASCALE, bf2f(v.y >> 16) * bf2f(z.y >> 16) * F8_ASCALE);
                w.y = pg8::cvt4_fp8(bf2f(v.z & 0xffffu) * bf2f(z.z & 0xffffu) * F8_ASCALE, bf2f(v.z >> 16) * bf2f(z.z >> 16) * F8_ASCALE, bf2f(v.w & 0xffffu) * bf2f(z.w & 0xffffu) * F8_ASCALE, bf2f(v.w >> 16) * bf2f(z.w >> 16) * F8_ASCALE);
                pg8::st8_wt(O1 + (rowb + qlo + row) * DM + h * 128 + chn * 8, w); }
        }
        __syncthreads();
    }
}

template <bool FIRST> struct RowRaw { u32x2 y[2][4]; f32x4 xf[2][4]; u32x2 xb[2][4]; };
template <bool FIRST>
__device__ __forceinline__ void row_load(RowRaw<FIRST>& R, int m0, int NGW, const bf16_t* Y, const float* xin, const bf16_t* X1b, int lane) {
    int mr[2]; mr[0] = m0; mr[1] = (m0 + NGW < MTOK) ? m0 + NGW : m0;
#pragma unroll
    for (int q = 0; q < 2; ++q) { const size_t ro = (size_t)mr[q] * DM;
#pragma unroll
        for (int jj = 0; jj < 4; ++jj) { R.y[q][jj] = __builtin_nontemporal_load((const u32x2*)(Y + ro) + lane + 64 * jj);
            if (FIRST) R.xf[q][jj] = __builtin_nontemporal_load((const f32x4*)(xin + ro) + lane + 64 * jj);
            else R.xb[q][jj] = __builtin_nontemporal_load((const u32x2*)(X1b + ro) + lane + 64 * jj); } }
}
template <bool FIRST>
__device__ __forceinline__ void row_proc(const RowRaw<FIRST>& R, int m0, int NGW, bf16_t* X1b, const f32x4 (&gpo)[4], float* out, const f32x4 (&gpr)[4], bf16_t* U, int lane) {
    f32x4 y[2][4], x[2][4]; float s[2] = {0.f, 0.f};
    int mr[2]; mr[0] = m0; mr[1] = (m0 + NGW < MTOK) ? m0 + NGW : m0;
#pragma unroll
    for (int q = 0; q < 2; ++q)
#pragma unroll
        for (int jj = 0; jj < 4; ++jj) { const u32x2 w = R.y[q][jj]; y[q][jj] = (f32x4){bf2f(w.x & 0xffffu), bf2f(w.x >> 16), bf2f(w.y & 0xffffu), bf2f(w.y >> 16)};
            if (FIRST) x[q][jj] = R.xf[q][jj];
            else { const u32x2 v = R.xb[q][jj]; x[q][jj] = (f32x4){bf2f(v.x & 0xffffu), bf2f(v.x >> 16), bf2f(v.y & 0xffffu), bf2f(v.y >> 16)}; } }
#pragma unroll
    for (int q = 0; q < 2; ++q)
#pragma unroll
        for (int jj = 0; jj < 4; ++jj) s[q] += (y[q][jj].x * y[q][jj].x + y[q][jj].y * y[q][jj].y) + (y[q][jj].z * y[q][jj].z + y[q][jj].w * y[q][jj].w);
    const float r0 = rsqrtf(wave_sum(s[0]) * (1.f / DM) + EPS), r1 = rsqrtf(wave_sum(s[1]) * (1.f / DM) + EPS);
    const bool two = (m0 + NGW < MTOK);
    float s1[2] = {0.f, 0.f};
#pragma unroll
    for (int q = 0; q < 2; ++q) { const size_t ro = (size_t)mr[q] * DM; const float r = q ? r1 : r0;
        if (q == 1 && !two) continue;
#pragma unroll
        for (int jj = 0; jj < 4; ++jj) { const f32x4 gv = gpo[jj]; x[q][jj] = x[q][jj] + y[q][jj] * r * gv;
            if (FIRST) { u32x2 w; w.x = cvtpk(x[q][jj].x, x[q][jj].y); w.y = cvtpk(x[q][jj].z, x[q][jj].w); pg8::st8_wt((u32x2*)(X1b + ro) + lane + 64 * jj, w);
                x[q][jj] = (f32x4){bf2f(w.x & 0xffffu), bf2f(w.x >> 16), bf2f(w.y & 0xffffu), bf2f(w.y >> 16)}; }
            else __builtin_nontemporal_store(x[q][jj], (f32x4*)(out + ro) + lane + 64 * jj);
            s1[q] += (x[q][jj].x * x[q][jj].x + x[q][jj].y * x[q][jj].y) + (x[q][jj].z * x[q][jj].z + x[q][jj].w * x[q][jj].w); } }
    if (FIRST) {
        const float q0 = rsqrtf(wave_sum(s1[0]) * (1.f / DM) + EPS), q1 = rsqrtf(wave_sum(s1[1]) * (1.f / DM) + EPS);
#pragma unroll
        for (int q = 0; q < 2; ++q) { if (q == 1 && !two) continue;
            const float rr = (q ? q1 : q0) * F8_USCALE; unsigned* uo = (unsigned*)((unsigned char*)U + (size_t)mr[q] * DM) + lane;
#pragma unroll
            for (int jj = 0; jj < 4; ++jj) { const f32x4 gv = gpr[jj]; pg8::st4_wt(uo + 64 * jj, pg8::cvt4_fp8(x[q][jj].x * rr * gv.x, x[q][jj].y * rr * gv.y, x[q][jj].z * rr * gv.z, x[q][jj].w * rr * gv.w)); } }
    }
}
template <bool FIRST>
__device__ __forceinline__ void row_phase(const Ctx& C, const bf16_t* Y, const float* xin, bf16_t* X1b, const float* gpost, float* out, const float* gpre, bf16_t* U) {
    const int gw = C.vcu * NWAVES + C.wave, NGW = C.G * NWAVES, lane = C.lane;
    if (gw >= MTOK) return;
    f32x4 gpo[4], gpr[4];
#pragma unroll
    for (int jj = 0; jj < 4; ++jj) { gpo[jj] = ((const f32x4*)gpost)[lane + 64 * jj]; gpr[jj] = FIRST ? ((const f32x4*)gpre)[lane + 64 * jj] : (f32x4){0.f, 0.f, 0.f, 0.f}; }
    RowRaw<FIRST> A, B;
    row_load<FIRST>(A, gw, NGW, Y, xin, X1b, lane);
#pragma unroll 1
    for (int m0 = gw; m0 < MTOK; m0 += 4 * NGW) {
        const int m1 = m0 + 2 * NGW, m2 = m0 + 4 * NGW;
        if (m1 < MTOK) row_load<FIRST>(B, m1, NGW, Y, xin, X1b, lane);
        row_proc<FIRST>(A, m0, NGW, X1b, gpo, out, gpr, U, lane);
        if (m1 >= MTOK) break;
        if (m2 < MTOK) row_load<FIRST>(A, m2, NGW, Y, xin, X1b, lane);
        row_proc<FIRST>(B, m1, NGW, X1b, gpo, out, gpr, U, lane);
    }
}

#define XB_TMO      128
#define XB_XCNT(j)  (256  + 64 * (j))
#define XB_XSUB(j)  (1280 + 64 * (j))
#define XB_XGEN(j)  (2304 + 64 * (j))
#define XB_TOP      3328
#define XB_TOPGEN   3392
#define XCD_BAR_WORDS 3456
#define XB_SPIN_CAP (1u << 18)

__device__ __forceinline__ unsigned xb_ld(unsigned* p)              { return __hip_atomic_load(p, __ATOMIC_RELAXED, __HIP_MEMORY_SCOPE_AGENT); }
__device__ __forceinline__ unsigned xb_add(unsigned* p, unsigned v) { return __hip_atomic_fetch_add(p, v, __ATOMIC_RELAXED, __HIP_MEMORY_SCOPE_AGENT); }
__device__ __forceinline__ unsigned xb_xcc_id() { return (unsigned)__builtin_amdgcn_s_getreg((3 << 11) | 20) & 0xFu; }
#define XB_SPIN(cond, bar) do { unsigned _sp = 0; while (cond) { __builtin_amdgcn_s_sleep(1); \
    if ((++_sp & 255u) == 0u) { if (xb_ld(&(bar)[XB_TMO])) break; if (_sp > XB_SPIN_CAP) { atomicAdd(&(bar)[XB_TMO], 1u); break; } } } } while (0)

struct XcdBarrier {
    unsigned* bar; unsigned x;
    volatile LAS unsigned* st;
};

__device__ __forceinline__ XcdBarrier xcd_barrier_post(unsigned* bar, volatile LAS unsigned* st) {
    XcdBarrier b; b.bar = bar; b.x = xb_xcc_id(); b.st = st;
    if (threadIdx.x == 0) (void)xb_add(&bar[XB_XCNT(b.x)], 1u);
    return b;
}
__device__ __forceinline__ void xcd_barrier_complete(unsigned* bar, unsigned x, unsigned& nloc, unsigned& nx) {
    const unsigned G = gridDim.x * gridDim.y * gridDim.z;
    unsigned sum, cnt, mine, sp = 0u;
    for (;;) {
        sum = 0u; cnt = 0u; mine = 0u;
#pragma unroll
        for (unsigned j = 0; j < 16; ++j) { const unsigned c = xb_ld(&bar[XB_XCNT(j)]); sum += c; cnt += (c > 0u) ? 1u : 0u; mine = (j == x) ? c : mine; }
        if (sum == G) break;
        __builtin_amdgcn_s_sleep(1);
        if ((++sp & 255u) == 0u) { if (xb_ld(&bar[XB_TMO])) break; if (sp > XB_SPIN_CAP) { atomicAdd(&bar[XB_TMO], 1u); break; } }
    }
    nloc = mine > 0u ? mine : 1u; nx = cnt > 0u ? cnt : 1u;
}

__device__ __forceinline__ void xcd_barrier(const XcdBarrier& b) {
    asm volatile("s_waitcnt vmcnt(0)" ::: "memory");
    __syncthreads();
    if (threadIdx.x == 0) {
        unsigned* bar = b.bar;
        __builtin_amdgcn_s_waitcnt(0);
        unsigned nloc = b.st[0], nx = b.st[1];
        if (nloc == 0u) { xcd_barrier_complete(bar, b.x, nloc, nx); b.st[0] = nloc; b.st[1] = nx; }
        const unsigned old = xb_add(&bar[XB_XSUB(b.x)], 1u);
        const unsigned gen = old / nloc;
        if (old + 1u == (gen + 1u) * nloc) {
            __builtin_amdgcn_fence(__ATOMIC_RELEASE, "agent");
            asm volatile("s_waitcnt vmcnt(0)" ::: "memory");
            const unsigned og = xb_add(&bar[XB_TOP], 1u);
            const unsigned tg = og / nx;
            if (og + 1u == (tg + 1u) * nx) xb_add(&bar[XB_TOPGEN], 1u);
            else XB_SPIN(xb_ld(&bar[XB_TOPGEN]) == tg, bar);
            __builtin_amdgcn_fence(__ATOMIC_ACQUIRE, "agent");
            xb_add(&bar[XB_XGEN(b.x)], 1u);
            asm volatile("s_waitcnt vmcnt(0)" ::: "memory");
        } else {
            XB_SPIN(xb_ld(&bar[XB_XGEN(b.x)]) == gen, bar);
            __builtin_amdgcn_fence(__ATOMIC_ACQUIRE, "agent");
            asm volatile("s_waitcnt vmcnt(0)" ::: "memory");
        }
    }
    __syncthreads();
}

#define MAKE_CTX() do { int tid_ = threadIdx.x; asm volatile("" : "+v"(tid_)); C.tid = tid_; C.lane = tid_ & 63; C.wave = __builtin_amdgcn_readfirstlane(tid_ >> 6); \
    C.G = gridDim.x; { const int bx = blockIdx.x; C.vcu = (C.G % 8 == 0) ? (bx % 8) * (C.G / 8) + bx / 8 : bx; } } while (0)
__global__ void __launch_bounds__(NTHREADS, 2) mk_fwd(Args args) {
    extern __shared__ __attribute__((aligned(16))) unsigned char lds_raw[];
    Ctx C;
    C.lds = (LAS unsigned char*)lds_raw;
    MAKE_CTX();
    unsigned char* ws = args.ws;
    const int lo = args.ph_lo, hi = args.ph_hi;
#if MK_ONE_LAUNCH
    cg::grid_group grid = cg::this_grid();
    volatile LAS unsigned* MISC = (volatile LAS unsigned*)(C.lds + LDS_MISC);
    if (C.tid < 4) MISC[C.tid] = 0u;
    __syncthreads();
    XcdBarrier xbar = xcd_barrier_post((unsigned*)(ws + WS_BAR), MISC);
#define GRID_SYNC(k) do { xcd_barrier(xbar); } while (0)
#else
#define GRID_SYNC(k) do {} while (0)
#endif
#define IN(k) (lo <= (k) && (k) < hi)
#define SEAM(k) do { if (IN(k) && IN((k) + 1)) { GRID_SYNC(k); if (PROBE_DUP == 100) GRID_SYNC(k); } } while (0)
    bf16_t* R0 = (bf16_t*)(ws + WS_R0); bf16_t* R1 = (bf16_t*)(ws + WS_R1); bf16_t* R2 = (bf16_t*)(ws + WS_R2); bf16_t* R3 = (bf16_t*)(ws + WS_R3); bf16_t* R4 = (bf16_t*)(ws + WS_R4);
    const int p1rem_ = ((MTOK / 256) * (N0PAD / 256)) % C.G, p1first_ = (p1rem_ > 0 && p1rem_ < C.G) ? p1rem_ : 0;
    if (IN(0)) { const int reps_ = (PROBE_DUP == 0 && args.ph_hi >= 10) ? 2 : 1; _Pragma("unroll 1") for (int rep_ = 0; rep_ < reps_; ++rep_) { p0_prologue(C, args, p1first_ == 0); __syncthreads(); } } SEAM(0);
    if (IN(1)) { MAKE_CTX();
        pg8::Gemm g{R0, (const bf16_t*)(ws + WS_W0T), MTOK, N0PAD, DM}; pg8::StaticOrder S; S.init(MTOK, N0PAD, C.G, (int)blockIdx.x);
        pg8::EpiMix<0> E{R1, R2, R2 + 8 * MiB, R2 + 16 * MiB, R2 + 24 * MiB, R3, R3 + 8 * MiB, R4, (float*)(ws + WS_GATE), QSCALE, C.lds + LDS_EPI, 1.0f};
        { const int nwg_ = (MTOK / 256) * (N0PAD / 256), full_ = nwg_ / C.G, rem_ = nwg_ - full_ * C.G;
          const int first_ = (rem_ > 0 && rem_ < C.G) ? rem_ : 0;
          if (first_ > 0 && (int)blockIdx.x >= first_) { p0_small_jobs(C, args, C.wave * (C.G - first_) + ((int)blockIdx.x - first_), (C.G - first_) * NWAVES); __syncthreads(); }
          if ((int)blockIdx.x >= first_) { late_transposes(C, args, first_); __syncthreads(); } }
        pg8::gemm_phase<pg8::EpiMix<0>, pg8::StaticOrder, true, true>(C.lds, g, S, E);
    } SEAM(1);
    if (IN(2)) { MAKE_CTX(); const int reps_ = (PROBE_DUP == 2 && args.ph_hi >= 10) ? 2 : 1; _Pragma("unroll 1") for (int rep_ = 0; rep_ < reps_; ++rep_) { compress_phase(C, args); __syncthreads(); } } SEAM(2);
    if (IN(3)) { MAKE_CTX(); const int reps_ = (PROBE_DUP == 3 && args.ph_hi >= 10) ? 2 : 1; _Pragma("unroll 1") for (int rep_ = 0; rep_ < reps_; ++rep_) { if (__builtin_amdgcn_readfirstlane((int)threadIdx.x) >= 256) __builtin_amdgcn_s_setprio(1); nsa_phase(C, args); __builtin_amdgcn_s_setprio(0); __syncthreads(); } } SEAM(3);
    if (IN(4)) { MAKE_CTX();
        pg8::Gemm g{R0, (const bf16_t*)(ws + WS_WO0T), MTOK, DM, DM}; pg8::StaticOrder S; S.init(MTOK, DM, C.G, (int)blockIdx.x);
        pg8::EpiMix<2> E{R1, nullptr, nullptr, nullptr, nullptr, nullptr, nullptr, nullptr, nullptr, 1.f, C.lds + LDS_EPI, 1.0f};
        pg8::gemm_phase<pg8::EpiMix<2>, pg8::StaticOrder, true, true>(C.lds, g, S, E);
    } SEAM(4);
    if (IN(5)) { MAKE_CTX(); row_phase<true>(C, R1, args.in[0], (bf16_t*)(ws + WS_X1B), args.in[3], nullptr, args.in[2] + DM, R0); } SEAM(5);
    if (IN(6)) { MAKE_CTX();
        pg8::Gemm g{R0, (const bf16_t*)(ws + WS_WDT), MTOK, N1, DM / 2}; pg8::StaticOrder S; S.init(MTOK, N1, C.G, (int)blockIdx.x);
        pg8::EpiMix<1> E{R1, R2, nullptr, nullptr, R3, nullptr, nullptr, R4, nullptr, QSCALE, C.lds + LDS_EPI, 1.0f / (F8_WSCALE * F8_USCALE)};
        pg8::gemm_phase<pg8::EpiMix<1>, pg8::StaticOrder, true, true, true>(C.lds, g, S, E);
    } SEAM(6);
    if (IN(7)) { MAKE_CTX(); const int reps_ = (PROBE_DUP == 7 && args.ph_hi >= 10) ? 2 : 1; _Pragma("unroll 1") for (int rep_ = 0; rep_ < reps_; ++rep_) { if (__builtin_amdgcn_readfirstlane((int)threadIdx.x) >= 256) __builtin_amdgcn_s_setprio(1); diff_phase(C, args); __builtin_amdgcn_s_setprio(0); __syncthreads(); } } SEAM(7);
    if (IN(8)) { MAKE_CTX();
        pg8::Gemm g{R0, (const bf16_t*)(ws + WS_WO1T), MTOK, DM, DM / 2}; pg8::StaticOrder S; S.init(MTOK, DM, C.G, (int)blockIdx.x);
        pg8::EpiMix<2> E{R1, nullptr, nullptr, nullptr, nullptr, nullptr, nullptr, nullptr, nullptr, 1.0f / (F8_WSCALE * F8_ASCALE), C.lds + LDS_EPI, 1.0f};
        pg8::gemm_phase<pg8::EpiMix<2>, pg8::StaticOrder, true, true, true>(C.lds, g, S, E);
    } SEAM(8);
    if (IN(9)) { MAKE_CTX(); row_phase<false>(C, R1, nullptr, (bf16_t*)(ws + WS_X1B), args.in[3] + DM, args.out, nullptr, nullptr); }
}

extern "C" void kernel_launch(void* const* d_in, const int* in_sizes, int n_in, void* d_out, int out_size, void* d_ws, size_t ws_size, hipStream_t stream) {
    static int grid = 0;
    if (grid == 0) {
        if (n_in != 19 || out_size != MTOK * DM || ws_size < WS_END) { fprintf(stderr, "kernel_launch: unexpected shapes n_in %d out %d ws %zu\n", n_in, out_size, ws_size); grid = -1; return; }
        int dev = 0, cus = 0, per_cu = 0;
        if (hipGetDevice(&dev) != hipSuccess || hipDeviceGetAttribute(&cus, hipDeviceAttributeMultiprocessorCount, dev) != hipSuccess) { grid = -1; return; }
        if (hipFuncSetAttribute((const void*)mk_fwd, hipFuncAttributeMaxDynamicSharedMemorySize, LDS_BYTES) != hipSuccess) { fprintf(stderr, "kernel_launch: hipFuncSetAttribute failed\n"); grid = -1; return; }
        if (hipOccupancyMaxActiveBlocksPerMultiprocessor(&per_cu, (const void*)mk_fwd, NTHREADS, LDS_BYTES) != hipSuccess || per_cu < 1) { fprintf(stderr, "kernel_launch: occupancy query says %d\n", per_cu); grid = -1; return; }
        grid = cus;
    }
    if (grid < 0) return;
    if (hipMemsetAsync((char*)d_ws + WS_BAR, 0, WS_BAR_BYTES, stream) != hipSuccess) { fprintf(stderr, "kernel_launch: memset failed\n"); return; }
    Args a{};
    for (int i = 0; i < 19; ++i) a.in[i] = (const float*)d_in[i];
    a.out = (float*)d_out; a.ws = (unsigned char*)d_ws;
#if MK_ONE_LAUNCH
    a.ph_lo = 0; a.ph_hi = 10;
    void* kargs[] = {&a};
    hipError_t e = hipLaunchCooperativeKernel((const void*)mk_fwd, dim3(grid), dim3(NTHREADS), kargs, LDS_BYTES, stream);
    if (e != hipSuccess) fprintf(stderr, "kernel_launch: cooperative launch failed: %s\n", hipGetErrorString(e));
#else
    for (int p = 0; p < 10; ++p) { a.ph_lo = p; a.ph_hi = p + 1; hipLaunchKernelGGL(mk_fwd, dim3(grid), dim3(NTHREADS), LDS_BYTES, stream, a); }
#endif
}
```
